# Optimizing an MI355X kernel written in HIP

```python
import math
import jax, jax.numpy as jnp
from jax import lax
import numpy as np

D_MODEL = 1024
BATCH = 8
SEQ = 2048
DEPTH = 2

N_A_LAYERS = DEPTH // 2
N_B_LAYERS = DEPTH - N_A_LAYERS
N_EVEN = (DEPTH + 1) // 2
N_ODD = DEPTH // 2
DEEPNORM_ALPHA = (2.0 * DEPTH) ** 0.25
DEEPNORM_BETA = (8.0 * DEPTH) ** -0.25
LN_EPS = 1e-5

DN_HEADS = 8
DN_HEAD_DIM = D_MODEL // DN_HEADS
DN_WIDTH = DN_HEADS * DN_HEAD_DIM
DN_CONV = 4
DN_CHUNK = 64
DN_NORM_EPS = 1e-6
DN_PROJ = 4 * DN_WIDTH + 2 * DN_HEADS

MB_HEADS = 8
MB_HEAD_DIM = D_MODEL // MB_HEADS
MB_WIDTH = MB_HEADS * MB_HEAD_DIM
MOBA_BLOCK = 256
MOBA_TOPK = 3
MOBA_Q_CHUNK = 8
ROPE_THETA = 10000.0
NEG_INF = -1e30

FFN_HIDDEN = D_MODEL * 7 // 2
N_EXPERTS = 8
TOP_K = 2

kernel_name = "yoco_deltanet_moba_moe_block"


def layer_norm(x, g, b):
    xf = x.astype(jnp.float32)
    mu = jnp.mean(xf, axis=-1, keepdims=True)
    var = jnp.mean(jnp.square(xf - mu), axis=-1, keepdims=True)
    return ((xf - mu) * lax.rsqrt(var + LN_EPS) * g + b).astype(x.dtype)


def apply_rope(t, positions):
    dh = t.shape[-1]
    half = dh // 2
    inv_freq = ROPE_THETA ** (-jnp.arange(half, dtype=jnp.float32) / half)
    ang = positions.astype(jnp.float32)[:, None] * inv_freq[None, :]
    cos = jnp.cos(ang)[None, :, None, :]
    sin = jnp.sin(ang)[None, :, None, :]
    tf = t.astype(jnp.float32)
    t1, t2 = tf[..., :half], tf[..., half:]
    return jnp.concatenate([t1 * cos - t2 * sin, t2 * cos + t1 * sin], axis=-1).astype(t.dtype)


def causal_short_conv(x, w):
    k_len = w.shape[0]
    s = x.shape[1]
    xp = jnp.pad(x, ((0, 0), (k_len - 1, 0), (0, 0)))
    y = xp[:, 0:s, :] * w[0]
    for j in range(1, k_len):
        y = y + xp[:, j:j + s, :] * w[j]
    return y


def l2norm(t):
    return t * lax.rsqrt(jnp.sum(t * t, axis=-1, keepdims=True) + DN_NORM_EPS)


def gated_delta_rule(q, k, v, g, beta):
    bsz, s, h, dk = q.shape
    dv = v.shape[-1]
    c = DN_CHUNK
    n = s // c

    def to_chunks(t):
        return jnp.moveaxis(t.reshape(bsz, n, c, h, *t.shape[3:]), 3, 1)

    q, k, v, g, beta = (to_chunks(t) for t in (q, k, v, g, beta))
    gc = jnp.cumsum(g, axis=-1)
    tri = jnp.tril(jnp.ones((c, c), dtype=bool))
    stri = jnp.tril(jnp.ones((c, c), dtype=bool), -1)
    decay = jnp.exp(jnp.where(tri, gc[..., :, None] - gc[..., None, :], NEG_INF))
    kb = k * beta[..., None]
    vb = v * beta[..., None]
    lmat = jnp.where(stri, jnp.einsum('bhnid,bhnjd->bhnij', kb, k) * decay, 0.0)
    amat = lmat + jnp.eye(c, dtype=jnp.float32)
    rhs = jnp.concatenate([vb, kb * jnp.exp(gc)[..., None]], axis=-1)
    sol = lax.linalg.triangular_solve(amat, rhs, left_side=True, lower=True, unit_diagonal=True)
    u, w = sol[..., :dv], sol[..., dv:]
    intra = jnp.einsum('bhnid,bhnjd->bhnij', q, k) * decay
    q_dec = q * jnp.exp(gc)[..., None]
    glast = gc[..., -1]
    k_dec = k * jnp.exp(glast[..., None] - gc)[..., None]
    xs = tuple(jnp.moveaxis(t, 2, 0) for t in (q_dec, k_dec, u, w, intra, glast))

    def step(state, inp):
        qd, kd, ui, wi, ai, gl = inp
        v_new = ui - jnp.einsum('bhcd,bhde->bhce', wi, state)
        o = jnp.einsum('bhcd,bhde->bhce', qd, state) + jnp.einsum('bhcs,bhse->bhce', ai, v_new)
        state = state * jnp.exp(gl)[..., None, None] + jnp.einsum('bhcd,bhce->bhde', kd, v_new)
        return state, o

    s0 = jnp.zeros((bsz, h, dk, dv), jnp.float32)
    _, o = lax.scan(step, s0, xs)
    o = jnp.moveaxis(o, 0, 2)
    return o.transpose(0, 2, 3, 1, 4).reshape(bsz, s, h, dv)


def gated_deltanet_mixer(x, w_in, conv_w, a_log, dt_bias, norm_w, w_out):
    bsz, s, _ = x.shape
    wd = DN_WIDTH
    proj = x @ w_in
    qkv = jax.nn.silu(causal_short_conv(proj[..., :3 * wd], conv_w))
    gate = proj[..., 3 * wd:4 * wd].reshape(bsz, s, DN_HEADS, DN_HEAD_DIM).astype(jnp.float32)
    a_in = proj[..., 4 * wd:4 * wd + DN_HEADS].astype(jnp.float32)
    b_in = proj[..., 4 * wd + DN_HEADS:].astype(jnp.float32)
    shp = (bsz, s, DN_HEADS, DN_HEAD_DIM)
    q = l2norm(qkv[..., :wd].reshape(shp).astype(jnp.float32)) * (DN_HEAD_DIM ** -0.5)
    k = l2norm(qkv[..., wd:2 * wd].reshape(shp).astype(jnp.float32))
    v = qkv[..., 2 * wd:].reshape(shp).astype(jnp.float32)
    beta = jax.nn.sigmoid(b_in)
    g = -jnp.exp(a_log.astype(jnp.float32)) * jax.nn.softplus(a_in + dt_bias.astype(jnp.float32))
    o = gated_delta_rule(q, k, v, g, beta)
    o = o * lax.rsqrt(jnp.mean(o * o, axis=-1, keepdims=True) + DN_NORM_EPS) * norm_w
    o = o * jax.nn.silu(gate)
    return o.reshape(bsz, s, wd).astype(x.dtype) @ w_out


def moba_shared_kv(h, w_kv):
    bsz, s, _ = h.shape
    kv = h @ w_kv
    k = kv[..., :MB_WIDTH].reshape(bsz, s, MB_HEADS, MB_HEAD_DIM)
    v = kv[..., MB_WIDTH:].reshape(bsz, s, MB_HEADS, MB_HEAD_DIM)
    k = apply_rope(k, jnp.arange(s))
    nb = -(-s // MOBA_BLOCK)
    pad = nb * MOBA_BLOCK - s

    def blocks(t):
        t = jnp.pad(t.astype(jnp.float32).transpose(0, 2, 1, 3), ((0, 0), (0, 0), (0, pad), (0, 0)))
        return t.reshape(bsz, MB_HEADS, nb, MOBA_BLOCK, MB_HEAD_DIM)

    kb, vb = blocks(k), blocks(v)
    kmean = jnp.mean(kb, axis=3)
    return kb, vb, kmean


def moba_mixer(x, w_q, w_o, kb, vb, kmean):
    bsz, s, _ = x.shape
    h, dh = MB_HEADS, MB_HEAD_DIM
    nb = kb.shape[2]
    sp = nb * MOBA_BLOCK
    scale = dh ** -0.5
    q = apply_rope((x @ w_q).reshape(bsz, s, h, dh), jnp.arange(s))
    q = q.astype(jnp.float32).transpose(0, 2, 1, 3)

    qb = jnp.pad(q, ((0, 0), (0, 0), (0, sp - s), (0, 0))).reshape(bsz, h, nb, MOBA_BLOCK, dh)
    s_own = jnp.einsum('bhnqd,bhnkd->bhnqk', qb, kb) * scale
    causal = jnp.tril(jnp.ones((MOBA_BLOCK, MOBA_BLOCK), dtype=bool))
    s_own = jnp.where(causal, s_own, NEG_INF)
    m_own = jnp.max(s_own, axis=-1)
    p_own = jnp.exp(s_own - m_own[..., None])
    l_own = jnp.sum(p_own, axis=-1).reshape(bsz, h, sp)[..., :s]
    o_own = jnp.einsum('bhnqk,bhnkd->bhnqd', p_own, vb).reshape(bsz, h, sp, dh)[:, :, :s]
    m_own = m_own.reshape(bsz, h, sp)[..., :s]

    n_sel = min(MOBA_TOPK, nb - 1)
    if n_sel == 0:
        out = o_own / l_own[..., None]
    else:
        q_blk = jnp.arange(s) // MOBA_BLOCK
        gate = jnp.einsum('bhsd,bhnd->bhsn', q, kmean)
        past = jnp.arange(nb)[None, :] < q_blk[:, None]
        gate = jnp.where(past, gate, NEG_INF)
        _, idx = lax.top_k(gate, n_sel)
        sel_ok = idx < q_blk[:, None]
        nc = s // MOBA_Q_CHUNK

        def to_chunks(t):
            return jnp.moveaxis(t.reshape(bsz, h, nc, MOBA_Q_CHUNK, *t.shape[3:]), 2, 0)

        def from_chunks(t):
            t = jnp.moveaxis(t, 0, 2)
            return t.reshape(bsz, h, s, *t.shape[4:])

        bi = jnp.arange(bsz)[:, None, None, None]
        hi = jnp.arange(h)[None, :, None, None]

        def attend(args):
            qc, ic, okc = args
            kg = kb[bi, hi, ic]
            sc = jnp.einsum('bhqd,bhqnkd->bhqnk', qc, kg) * scale
            sc = jnp.where(okc[..., None], sc, NEG_INF)
            m = jnp.max(sc, axis=(-2, -1))
            p = jnp.where(okc[..., None], jnp.exp(sc - m[..., None, None]), 0.0)
            l = jnp.sum(p, axis=(-2, -1))
            vg = vb[bi, hi, ic]
            o = jnp.einsum('bhqnk,bhqnkd->bhqd', p, vg)
            return m, l, o

        m_s, l_s, o_s = lax.map(attend, (to_chunks(q), to_chunks(idx), to_chunks(sel_ok)))
        m_s, l_s, o_s = from_chunks(m_s), from_chunks(l_s), from_chunks(o_s)
        m = jnp.maximum(m_own, m_s)
        w1 = jnp.exp(m_own - m)
        w2 = jnp.exp(m_s - m)
        out = (o_own * w1[..., None] + o_s * w2[..., None]) / (l_own * w1 + l_s * w2)[..., None]
    out = out.transpose(0, 2, 1, 3).reshape(bsz, s, MB_WIDTH).astype(x.dtype)
    return out @ w_o


def swiglu(x, w1, w3, w2):
    return (jax.nn.silu(x @ w1) * (x @ w3)) @ w2


def moe_ffn(x, w_router, w1, w3, w2):
    xt = x.reshape(-1, x.shape[-1])
    probs = jax.nn.softmax((xt @ w_router).astype(jnp.float32), axis=-1)
    top_p, top_i = lax.top_k(probs, TOP_K)
    top_p = top_p / jnp.sum(top_p, axis=-1, keepdims=True)
    gates = jnp.sum(jax.nn.one_hot(top_i, N_EXPERTS, dtype=jnp.float32) * top_p[..., None], axis=-2)
    y = jnp.zeros(xt.shape, jnp.float32)
    for e in range(N_EXPERTS):
        y = y + gates[:, e:e + 1] * swiglu(xt, w1[e], w3[e], w2[e])
    return y.reshape(x.shape).astype(x.dtype)


def setup_inputs(seed: int = 0) -> dict:
    key = jax.random.key(seed)
    ks = jax.random.split(key, 24)
    f32 = jnp.float32

    def nrm(i, shape, scale):
        return jax.random.normal(ks[i], shape, f32) * scale

    x = nrm(0, (BATCH, SEQ, D_MODEL), 1.0)
    a_w_in = nrm(1, (N_A_LAYERS, D_MODEL, DN_PROJ), D_MODEL ** -0.5)
    a_w_in = a_w_in.at[:, :, 2 * DN_WIDTH:3 * DN_WIDTH].multiply(DEEPNORM_BETA)
    a_conv_w = nrm(2, (N_A_LAYERS, DN_CONV, 3 * DN_WIDTH), DN_CONV ** -0.5)
    a_log_decay = jnp.log(jax.random.uniform(ks[3], (N_A_LAYERS, DN_HEADS), f32, 1.0, 16.0))
    dt = jnp.exp(jax.random.uniform(ks[4], (N_A_LAYERS, DN_HEADS), f32, math.log(1e-3), math.log(1e-1)))
    a_dt_bias = dt + jnp.log(-jnp.expm1(-dt))
    a_norm_w = 1.0 + nrm(5, (N_A_LAYERS, DN_HEAD_DIM), 0.02)
    a_w_out = nrm(6, (N_A_LAYERS, DN_WIDTH, D_MODEL), DN_WIDTH ** -0.5 * DEEPNORM_BETA)
    b_w_kv = nrm(7, (D_MODEL, 2 * MB_WIDTH), D_MODEL ** -0.5)
    b_w_kv = b_w_kv.at[:, MB_WIDTH:].multiply(DEEPNORM_BETA)
    b_w_q = nrm(8, (N_B_LAYERS, D_MODEL, MB_WIDTH), D_MODEL ** -0.5)
    b_w_o = nrm(9, (N_B_LAYERS, MB_WIDTH, D_MODEL), MB_WIDTH ** -0.5 * DEEPNORM_BETA)
    ffn_w1 = nrm(10, (N_EVEN, D_MODEL, FFN_HIDDEN), D_MODEL ** -0.5)
    ffn_w3 = nrm(11, (N_EVEN, D_MODEL, FFN_HIDDEN), D_MODEL ** -0.5)
    ffn_w2 = nrm(12, (N_EVEN, FFN_HIDDEN, D_MODEL), FFN_HIDDEN ** -0.5 * DEEPNORM_BETA)
    moe_router = nrm(13, (N_ODD, D_MODEL, N_EXPERTS), D_MODEL ** -0.5)
    moe_w1 = nrm(14, (N_ODD, N_EXPERTS, D_MODEL, FFN_HIDDEN), D_MODEL ** -0.5)
    moe_w3 = nrm(15, (N_ODD, N_EXPERTS, D_MODEL, FFN_HIDDEN), D_MODEL ** -0.5)
    moe_w2 = nrm(16, (N_ODD, N_EXPERTS, FFN_HIDDEN, D_MODEL), FFN_HIDDEN ** -0.5 * DEEPNORM_BETA)
    ln_g = 1.0 + nrm(17, (DEPTH, 2, D_MODEL), 0.02)
    ln_b = nrm(18, (DEPTH, 2, D_MODEL), 0.02)
    return {"x": x, "a_w_in": a_w_in, "a_conv_w": a_conv_w, "a_log_decay": a_log_decay,
            "a_dt_bias": a_dt_bias, "a_norm_w": a_norm_w, "a_w_out": a_w_out,
            "b_w_kv": b_w_kv, "b_w_q": b_w_q, "b_w_o": b_w_o,
            "ffn_w1": ffn_w1, "ffn_w3": ffn_w3, "ffn_w2": ffn_w2,
            "moe_router": moe_router, "moe_w1": moe_w1, "moe_w3": moe_w3, "moe_w2": moe_w2,
            "ln_g": ln_g, "ln_b": ln_b}


def reference(x, a_w_in, a_conv_w, a_log_decay, a_dt_bias, a_norm_w, a_w_out, b_w_kv, b_w_q, b_w_o,
              ffn_w1, ffn_w3, ffn_w2, moe_router, moe_w1, moe_w3, moe_w2, ln_g, ln_b):
    shared = None
    for layer in range(DEPTH):
        if layer < N_A_LAYERS:
            i = layer
            mix = gated_deltanet_mixer(x, a_w_in[i], a_conv_w[i], a_log_decay[i], a_dt_bias[i],
                                       a_norm_w[i], a_w_out[i])
        else:
            if shared is None:
                shared = moba_shared_kv(x, b_w_kv)
            j = layer - N_A_LAYERS
            mix = moba_mixer(x, b_w_q[j], b_w_o[j], *shared)
        x = layer_norm(DEEPNORM_ALPHA * x + mix, ln_g[layer, 0], ln_b[layer, 0])
        f = layer // 2
        if layer % 2 == 0:
            ffn = swiglu(x, ffn_w1[f], ffn_w3[f], ffn_w2[f])
        else:
            ffn = moe_ffn(x, moe_router[f], moe_w1[f], moe_w3[f], moe_w2[f])
        x = layer_norm(DEEPNORM_ALPHA * x + ffn, ln_g[layer, 1], ln_b[layer, 1])
    return x
```

```cpp
#include <hip/hip_runtime.h>
#include <cstdint>
#include <cstdio>
#define LAS __attribute__((address_space(3)))
typedef unsigned short bf16_t;
typedef short bf16x8 __attribute__((ext_vector_type(8)));
typedef float f32x4 __attribute__((ext_vector_type(4)));
typedef float f32x2 __attribute__((ext_vector_type(2)));
typedef unsigned u32x4 __attribute__((ext_vector_type(4)));
typedef unsigned u32x2 __attribute__((ext_vector_type(2)));

constexpr int NB = 8, SEQ = 2048, DM = 1024, NT = NB * SEQ, NH = 8, DH = 128;
constexpr int NPROJ = 4112, FF = 3584, NE = 8, MAXSLOT = 34816;
constexpr float ALPHA = 1.41421356237309515f;
constexpr float LN_EPS = 1e-5f;
constexpr int NTHR = 512;

__device__ __forceinline__ int otid() { int t = threadIdx.x; asm volatile("" : "+v"(t)); return t; }
__device__ __forceinline__ unsigned cvt_pk_bf16(float lo, float hi) { unsigned r; asm volatile("v_cvt_pk_bf16_f32 %0, %1, %2" : "=v"(r) : "v"(lo), "v"(hi)); return r; }
__device__ __forceinline__ float bf2f(unsigned short b) { return __uint_as_float(((unsigned)b) << 16); }
__device__ __forceinline__ float bflo(unsigned w) { return __uint_as_float(w << 16); }
__device__ __forceinline__ float bfhi(unsigned w) { return __uint_as_float(w & 0xffff0000u); }
__device__ __forceinline__ float silu_f(float x) { return x / (1.f + __expf(-x)); }

namespace pg8 {
constexpr int BM = 256, BK = 64, HALF = 128, HTB = HALF * BK * 2, STAGE_BYTES = 8 * HTB, NXCD = 8, WGM = 8;
__host__ __device__ __forceinline__ int lds_byte(int r, int c) { const int st = (r >> 4) * 2 + (c >> 5), rr = r & 15, cc = c & 31, ob = rr * 64 + cc * 2; return st * 1024 + (ob ^ (((ob >> 9) & 1) << 5)); }
__host__ __device__ __forceinline__ void stage_rc(int b, int& R, int& C) { const int st = b / 1024, sb = b % 1024, swz = sb ^ (((sb >> 9) & 1) << 5); R = (st >> 1) * 16 + swz / 64; C = (st & 1) * 32 + (swz % 64) / 2; }
__host__ __device__ __forceinline__ int perm32(int rho) { const int n = rho >> 4, i = rho & 15; return 8 * (i >> 2) + 4 * n + (i & 3); }

struct Unit { int pm, pn, arow, pad; const char* A; const char* B; };

__device__ __forceinline__ bool tile_order(long L, int nM, int nN, int& pm, int& pn) {
    const int nwg = nM * nN; if (L >= nwg) return false;
    int wgid = (int)L; { const int q = nwg / NXCD, r = nwg % NXCD, xcd = wgid % NXCD, off = wgid / NXCD; wgid = (xcd < r ? xcd * (q + 1) : r * (q + 1) + (xcd - r) * q) + off; }
    const int nig = WGM * nN, gid = wgid / nig, fm = gid * WGM, gsz = (nM - fm) < WGM ? (nM - fm) : WGM;
    pm = fm + ((wgid % nig) % gsz); pn = (wgid % nig) / gsz; return true;
}
struct DenseSched {
    const char* A; const char* Bt; int nM, nN, G, c; size_t tstep;
    __device__ __forceinline__ void init(const void* A_, const void* Bt_, int M, int N, int K) { A = (const char*)A_; Bt = (const char*)Bt_; nM = M / BM; nN = N / BM; G = (int)gridDim.x; c = (int)blockIdx.x; tstep = (size_t)BM * K * 2; }
    __device__ __forceinline__ bool next(int i, Unit& u) const {
        int pm, pn; if (!tile_order((long)i * G + c, nM, nN, pm, pn)) return false;
        u.pm = pm; u.pn = pn; u.arow = 0; u.pad = 0; u.A = A + (size_t)pm * tstep; u.B = Bt + (size_t)pn * tstep; return true;
    }
};

template <class Epi, class Sched, bool GATHER>
__device__ __forceinline__ void gemm_phase(LAS unsigned char* lds, const int K, const Sched& S, const Epi& E, const int* __restrict__ gidx) {
    const int tid = otid(), wid = __builtin_amdgcn_readfirstlane(tid >> 6), lane = tid & 63, wr = wid >> 2, wc = wid & 3, fr = lane & 15, fq = lane >> 4;
    const int nt = K / BK;
    unsigned voffB[2]; unsigned aoffc[2][2], aoffn[2][2]; int rA[2], cA2[2];
    const size_t kstep = (size_t)(BK * 2);
    const unsigned hstep = (unsigned)HALF * (unsigned)K * 2u;
#pragma unroll
    for (int i = 0; i < 2; ++i) { int R, C; stage_rc(tid * 16 + i * 8192, R, C); const int Rb = Epi::PERM ? ((R & ~31) + perm32(R & 31)) : R;
        rA[i] = R; cA2[i] = C * 2; voffB[i] = (unsigned)(Rb * K + C) * 2u;
        aoffc[0][i] = (unsigned)(R * K + C) * 2u; aoffc[1][i] = aoffc[0][i] + hstep; aoffn[0][i] = aoffc[0][i]; aoffn[1][i] = aoffc[1][i]; }
    const unsigned ldsw = (unsigned)wid * 1024u;
    const int aoff = lds_byte(wr * 64 + fr, fq * 8), boff = lds_byte(wc * 32 + fr, fq * 8);
#define PG8_SA(b, h) (((b) * 2 + (h)) * HTB)
#define PG8_SB(b, h) ((4 + (b) * 2 + (h)) * HTB)
#define PG8_STAGE_A(bufoff, gbase, offs) do { _Pragma("unroll") for (int _i = 0; _i < 2; ++_i) \
        __builtin_amdgcn_global_load_lds((const unsigned*)((const char*)(gbase) + (offs)[_i]), (LAS unsigned*)(lds + (bufoff) + ldsw + _i * 8192), 16, 0, 0); } while (0)
#define PG8_STAGE_B(bufoff, gbase) do { _Pragma("unroll") for (int _i = 0; _i < 2; ++_i) \
        __builtin_amdgcn_global_load_lds((const unsigned*)((const char*)(gbase) + voffB[_i]), (LAS unsigned*)(lds + (bufoff) + ldsw + _i * 8192), 16, 0, 0); } while (0)
#define PG8_LDA(dst, b, h) do { _Pragma("unroll") for (int m = 0; m < 4; ++m) _Pragma("unroll") for (int k = 0; k < 2; ++k) dst[m][k] = *(const LAS bf16x8*)(lds + PG8_SA(b, h) + aoff + m * 2048 + k * 1024); } while (0)
#define PG8_LDB(dst, b, h) do { _Pragma("unroll") for (int n = 0; n < 2; ++n) _Pragma("unroll") for (int k = 0; k < 2; ++k) dst[n][k] = *(const LAS bf16x8*)(lds + PG8_SB(b, h) + boff + n * 2048 + k * 1024); } while (0)
#define PG8_MMA(ai, bj, At, Bt) do { __builtin_amdgcn_s_setprio(1); _Pragma("unroll") for (int m = 0; m < 4; ++m) _Pragma("unroll") for (int n = 0; n < 2; ++n) _Pragma("unroll") for (int k = 0; k < 2; ++k) \
        acc[ai][bj][m][n] = __builtin_amdgcn_mfma_f32_16x16x32_bf16(Bt[n][k], At[m][k], acc[ai][bj][m][n], 0, 0, 0); __builtin_amdgcn_s_setprio(0); } while (0)
#define PG8_WAIT_V(n) asm volatile("s_waitcnt vmcnt(" #n ")" ::: "memory")
#define PG8_WAIT_L(n) asm volatile("s_waitcnt lgkmcnt(" #n ")" ::: "memory")
#define PG8_BAR __builtin_amdgcn_s_barrier()
#define PG8_SCHED __builtin_amdgcn_sched_barrier(0)
#define PG8_GOFFS(dst, ui_) do { if (GATHER) { _Pragma("unroll") for (int _h = 0; _h < 2; ++_h) _Pragma("unroll") for (int _i = 0; _i < 2; ++_i) \
        dst[_h][_i] = gtab[(ui_) * 256 + _h * HALF + rA[_i]] + (unsigned)cA2[_i]; } } while (0)
    Unit cur, nxt; int ui = 0;
    if (!S.next(0, cur)) return;
    LAS unsigned* gtab = (LAS unsigned*)(lds + STAGE_BYTES);
    if (GATHER) { Unit uu;
        for (int i = 0; i < 16 && S.next(i, uu); ++i) { if (tid < 256) { int t_ = gidx[uu.arow + tid]; t_ = t_ < 0 ? 0 : t_; gtab[i * 256 + tid] = (unsigned)t_ * (unsigned)(K * 2); } }
        __syncthreads(); }
    f32x4 acc[2][2][4][2];
#pragma unroll
    for (int a = 0; a < 2; ++a)
#pragma unroll
        for (int b = 0; b < 2; ++b)
#pragma unroll
            for (int m = 0; m < 4; ++m)
#pragma unroll
                for (int n = 0; n < 2; ++n) acc[a][b][m][n] = (f32x4){0.f, 0.f, 0.f, 0.f};
    bf16x8 At[4][2], B0[2][2], B1[2][2];
    const char* cA = cur.A; const char* cB = cur.B;
    PG8_GOFFS(aoffc, 0);
    PG8_STAGE_B(PG8_SB(0, 0), cB); PG8_STAGE_A(PG8_SA(0, 0), cA, aoffc[0]); PG8_STAGE_B(PG8_SB(0, 1), cB + hstep); PG8_STAGE_A(PG8_SA(0, 1), cA, aoffc[1]);
    if (wr == 1) PG8_BAR;
    PG8_WAIT_V(4); PG8_BAR;
    PG8_STAGE_B(PG8_SB(1, 0), cB + kstep); PG8_STAGE_A(PG8_SA(1, 0), cA + kstep, aoffc[0]); PG8_STAGE_B(PG8_SB(1, 1), cB + hstep + kstep);
    PG8_WAIT_V(6); PG8_BAR;
    for (;;) {
        const bool has_next = S.next(ui + 1, nxt);
        const char* nA = has_next ? nxt.A : cA; const char* nB = has_next ? nxt.B : cB;
        if (GATHER) { if (has_next) { PG8_GOFFS(aoffn, ui + 1); } else {
#pragma unroll
            for (int h = 0; h < 2; ++h)
#pragma unroll
                for (int i = 0; i < 2; ++i) aoffn[h][i] = aoffc[h][i]; } }
        for (int t = 0; t < nt; t += 2) {
            const bool last = (t == nt - 2);
            const char* a1 = cA + (size_t)(t + 1) * kstep;
            const char* a2 = last ? nA : cA + (size_t)(t + 2) * kstep; const char* b2 = last ? nB : cB + (size_t)(t + 2) * kstep;
            const char* a3 = a2 + kstep; const char* b3 = b2 + kstep;
            unsigned a2o[2][2];
#pragma unroll
            for (int h = 0; h < 2; ++h)
#pragma unroll
                for (int i = 0; i < 2; ++i) a2o[h][i] = (GATHER && last) ? aoffn[h][i] : aoffc[h][i];
            PG8_LDB(B0, 0, 0); PG8_SCHED; PG8_LDA(At, 0, 0); PG8_STAGE_A(PG8_SA(1, 1), a1, aoffc[1]);
            PG8_WAIT_L(8); PG8_BAR; PG8_WAIT_L(0); PG8_MMA(0, 0, At, B0); PG8_BAR; PG8_SCHED;
            PG8_LDB(B1, 0, 1); PG8_STAGE_B(PG8_SB(0, 0), b2);
            PG8_BAR; PG8_WAIT_L(0); PG8_MMA(0, 1, At, B1); PG8_BAR;
            PG8_LDA(At, 0, 1); PG8_STAGE_A(PG8_SA(0, 0), a2, a2o[0]);
            PG8_BAR; PG8_WAIT_L(0); PG8_MMA(1, 0, At, B0); PG8_BAR; PG8_SCHED;
            PG8_STAGE_B(PG8_SB(0, 1), b2 + hstep);
            PG8_WAIT_V(6); PG8_BAR; PG8_MMA(1, 1, At, B1); PG8_BAR;
            PG8_LDB(B0, 1, 0); PG8_SCHED; PG8_LDA(At, 1, 0); PG8_STAGE_A(PG8_SA(0, 1), a2, a2o[1]);
            PG8_WAIT_L(8); PG8_BAR; PG8_WAIT_L(0); PG8_MMA(0, 0, At, B0); PG8_BAR; PG8_SCHED;
            PG8_LDB(B1, 1, 1); PG8_STAGE_B(PG8_SB(1, 0), b3);
            PG8_BAR; PG8_WAIT_L(0); PG8_MMA(0, 1, At, B1); PG8_BAR;
            PG8_LDA(At, 1, 1); PG8_STAGE_A(PG8_SA(1, 0), a3, a2o[0]);
            PG8_BAR; PG8_WAIT_L(0); PG8_MMA(1, 0, At, B0); PG8_BAR; PG8_SCHED;
            PG8_STAGE_B(PG8_SB(1, 1), b3 + hstep);
            PG8_WAIT_V(6); PG8_BAR; PG8_MMA(1, 1, At, B1); PG8_BAR;
        }
        E(acc, cur, wr, wc, fr, fq);
        if (!has_next) break;
#pragma unroll
        for (int a = 0; a < 2; ++a)
#pragma unroll
            for (int b = 0; b < 2; ++b)
#pragma unroll
                for (int m = 0; m < 4; ++m)
#pragma unroll
                    for (int n = 0; n < 2; ++n) acc[a][b][m][n] = (f32x4){0.f, 0.f, 0.f, 0.f};
        cur = nxt; cA = nA; cB = nB; ++ui;
        if (GATHER) {
#pragma unroll
            for (int h = 0; h < 2; ++h)
#pragma unroll
                for (int i = 0; i < 2; ++i) aoffc[h][i] = aoffn[h][i]; }
    }
    PG8_WAIT_V(0);
    if (wr == 0) PG8_BAR;
    PG8_BAR;
#undef PG8_SA
#undef PG8_SB
#undef PG8_STAGE_A
#undef PG8_STAGE_B
#undef PG8_LDA
#undef PG8_LDB
#undef PG8_MMA
#undef PG8_WAIT_V
#undef PG8_WAIT_L
#undef PG8_BAR
#undef PG8_SCHED
#undef PG8_GOFFS
}

struct EpiBf16 {
    static constexpr bool PERM = true;
    bf16_t* O; int ldc; int pad;
    __device__ __forceinline__ void operator()(const f32x4 (&acc)[2][2][4][2], const Unit& u, int wr, int wc, int fr, int fq) const {
        const int row0 = u.pm * BM + wr * 64 + fr, col0 = u.pn * BM + wc * 32 + 8 * fq;
#pragma unroll
        for (int ai = 0; ai < 2; ++ai)
#pragma unroll
            for (int m = 0; m < 4; ++m) { bf16_t* rowp = O + (size_t)(row0 + ai * HALF + m * 16) * ldc + col0;
#pragma unroll
                for (int bj = 0; bj < 2; ++bj) { const f32x4 v0 = acc[ai][bj][m][0], v1 = acc[ai][bj][m][1];
                    u32x4 w; w.x = cvt_pk_bf16(v0[0], v0[1]); w.y = cvt_pk_bf16(v0[2], v0[3]); w.z = cvt_pk_bf16(v1[0], v1[1]); w.w = cvt_pk_bf16(v1[2], v1[3]);
                    *(u32x4*)(rowp + bj * HALF) = w; } }
    }
};
struct EpiResF32 {
    static constexpr bool PERM = false;
    float* C; const float* X; int ldc; int pad;
    __device__ __forceinline__ void operator()(const f32x4 (&acc)[2][2][4][2], const Unit& u, int wr, int wc, int fr, int fq) const {
        const int row0 = u.pm * BM + wr * 64 + fr, col0 = u.pn * BM + wc * 32 + 4 * fq;
        f32x4 xv[2][4];
#pragma unroll
        for (int q = 0; q < 4; ++q) xv[0][q] = *(const f32x4*)(X + (size_t)row0 * ldc + col0 + (q >> 1) * HALF + (q & 1) * 16);
#pragma unroll
        for (int gI = 0; gI < 8; ++gI) { const int ai = gI >> 2, m = gI & 3; const size_t off = (size_t)(row0 + ai * HALF + m * 16) * ldc + col0;
            if (gI + 1 < 8) { const int ai2 = (gI + 1) >> 2, m2 = (gI + 1) & 3; const size_t off2 = (size_t)(row0 + ai2 * HALF + m2 * 16) * ldc + col0;
#pragma unroll
                for (int q = 0; q < 4; ++q) xv[(gI + 1) & 1][q] = *(const f32x4*)(X + off2 + (q >> 1) * HALF + (q & 1) * 16); }
#pragma unroll
            for (int q = 0; q < 4; ++q) *(f32x4*)(C + off + (q >> 1) * HALF + (q & 1) * 16) = xv[gI & 1][q] * ALPHA + acc[ai][q >> 1][m][q & 1]; }
    }
};
}

struct CvtJob { const float* src0; const float* src1; bf16_t* dst; int K, N, ld, mode, tile0, pad; };
constexpr int NJOBS = 24;
struct CvtTable { CvtJob j[NJOBS]; int ntiles; int pad; };

__device__ __forceinline__ void cvt_tile_src(const CvtJob& jb, int tl, const float*& src, bf16_t*& dst) {
    const int nk = jb.K >> 7; const int tn = tl / nk, tk = tl - tn * nk; const int n0 = tn * 64, k0 = tk * 128;
    const float* s = jb.src0; int col0 = n0;
    if (jb.mode == 1) { const int pn = n0 >> 8, bj = (n0 >> 7) & 1, j0 = n0 & 127; s = bj ? jb.src1 : jb.src0; col0 = 128 * pn + j0; }
    else if (jb.mode == 2) { const int pn = n0 >> 8, bj = (n0 >> 7) & 1, j0 = n0 & 127; col0 = (2 * pn + (j0 >> 6)) * 128 + 64 * bj; }
    src = s + (size_t)k0 * jb.ld + col0; dst = jb.dst + (size_t)n0 * jb.K + k0;
}
__device__ __forceinline__ void phase_cvt_weights(LAS unsigned char* lds, const CvtTable& tb, const int t_begin, const int t_end) {
    LAS float* tile = (LAS float*)lds;
    const int tid = otid();
    int tl = t_begin + blockIdx.x; if (tl >= t_end) return;
    auto find = [&](int t) { int ji = 0;
#pragma unroll 1
        for (int q = 1; q < NJOBS; ++q) if (t >= tb.j[q].tile0) ji = q; return ji; };
    f32x4 v[4]; const float* src; bf16_t* dst; int ji = find(tl); int ld = tb.j[ji].ld, Kd = tb.j[ji].K;
    cvt_tile_src(tb.j[ji], tl - tb.j[ji].tile0, src, dst);
#pragma unroll
    for (int i = 0; i < 4; ++i) { const int idx = tid + 512 * i; v[i] = *(const f32x4*)(src + (size_t)(idx >> 4) * ld + (idx & 15) * 4); }
    for (;;) {
        __syncthreads();
#pragma unroll
        for (int i = 0; i < 4; ++i) { const int idx = tid + 512 * i; const int r = idx >> 4, c = (idx & 15) * 4; LAS float* p = tile + r * 65 + c; p[0] = v[i][0]; p[1] = v[i][1]; p[2] = v[i][2]; p[3] = v[i][3]; }
        bf16_t* dcur = dst; const int Kcur = Kd;
        const int tn = tl + gridDim.x; const bool more = tn < t_end;
        if (more) { ji = find(tn); ld = tb.j[ji].ld; Kd = tb.j[ji].K; cvt_tile_src(tb.j[ji], tn - tb.j[ji].tile0, src, dst);
#pragma unroll
            for (int i = 0; i < 4; ++i) { const int idx = tid + 512 * i; v[i] = *(const f32x4*)(src + (size_t)(idx >> 4) * ld + (idx & 15) * 4); } }
        __syncthreads();
        const int kc = tid & 15, nn = tid >> 4;
#pragma unroll
        for (int p = 0; p < 2; ++p) { const int n = nn + 32 * p; float e[8];
#pragma unroll
            for (int i = 0; i < 8; ++i) e[i] = tile[(8 * kc + i) * 65 + n];
            u32x4 w; w.x = cvt_pk_bf16(e[0], e[1]); w.y = cvt_pk_bf16(e[2], e[3]); w.z = cvt_pk_bf16(e[4], e[5]); w.w = cvt_pk_bf16(e[6], e[7]);
            *(u32x4*)(dcur + (size_t)n * Kcur + 8 * kc) = w; }
        if (!more) break; tl = tn;
    }
    __syncthreads();
}

__device__ __forceinline__ void phase_x_prep(LAS unsigned char* lds, const float* __restrict__ x, const float* __restrict__ w_in, const float* __restrict__ a_log, const float* __restrict__ dt_bias,
                                             bf16_t* __restrict__ xb, float* __restrict__ g, float* __restrict__ beta) {
    LAS float* wab = (LAS float*)lds;
    const int tid = otid(), wid = tid >> 6, lane = tid & 63;
    for (int i = tid; i < 16 * 1024; i += NTHR) { const int c = i >> 4, j = i & 15; wab[j * 1028 + c] = w_in[(size_t)c * NPROJ + 4096 + j]; }
    __syncthreads();
    for (int row = blockIdx.x * 8 + wid; row < NT; row += gridDim.x * 8) {
        float acc[16];
#pragma unroll
        for (int j = 0; j < 16; ++j) acc[j] = 0.f;
#pragma unroll
        for (int i = 0; i < 4; ++i) { const int c = 4 * lane + 256 * i; const f32x4 xv = *(const f32x4*)(x + (size_t)row * DM + c);
            u32x2 w; w.x = cvt_pk_bf16(xv[0], xv[1]); w.y = cvt_pk_bf16(xv[2], xv[3]); *(u32x2*)(xb + (size_t)row * DM + c) = w;
#pragma unroll
            for (int j = 0; j < 16; ++j) { const f32x4 wv = *(const LAS f32x4*)(wab + j * 1028 + c); acc[j] += xv[0] * wv[0] + xv[1] * wv[1] + xv[2] * wv[2] + xv[3] * wv[3]; } }
#pragma unroll
        for (int j = 0; j < 16; ++j) { float s = acc[j]; for (int o = 32; o >= 1; o >>= 1) s += __shfl_xor(s, o); acc[j] = s; }
        float a = 0.f, b = 0.f;
#pragma unroll
        for (int j = 0; j < 8; ++j) { a = (lane == j) ? acc[j] : a; b = (lane == j) ? acc[8 + j] : b; }
        if (lane < 8) { const float xx = a + dt_bias[lane]; const float sp = xx > 20.f ? xx : log1pf(expf(xx));
            g[row * 8 + lane] = -expf(a_log[lane]) * sp; beta[row * 8 + lane] = 1.f / (1.f + expf(-b)); }
    }
    __syncthreads();
}
__device__ __forceinline__ void phase_rope_table(float* __restrict__ cs, float* __restrict__ sn) {
    for (int i = blockIdx.x * NTHR + otid(); i < SEQ * 64; i += gridDim.x * NTHR) { const int pos = i >> 6, f = i & 63;
        const double inv = pow(10000.0, -(double)f / 64.0); const double ang = (double)pos * inv; cs[i] = (float)cos(ang); sn[i] = (float)sin(ang); }
}

namespace pg8 {
struct EpiSwiGLU {
    static constexpr bool PERM = true;
    bf16_t* Hh; int ldc; int row_off;
    __device__ __forceinline__ void operator()(const f32x4 (&acc)[2][2][4][2], const Unit& u, int wr, int wc, int fr, int fq) const {
        const int row0 = u.pm * BM + wr * 64 + fr - row_off, col0 = u.pn * HALF + wc * 32 + 8 * fq;
#pragma unroll
        for (int ai = 0; ai < 2; ++ai)
#pragma unroll
            for (int m = 0; m < 4; ++m) { bf16_t* rowp = Hh + (size_t)(row0 + ai * HALF + m * 16) * ldc + col0;
                float h[8];
#pragma unroll
                for (int n = 0; n < 2; ++n)
#pragma unroll
                    for (int i = 0; i < 4; ++i) { const float g = acc[ai][0][m][n][i], up = acc[ai][1][m][n][i]; h[n * 4 + i] = g * __builtin_amdgcn_rcpf(1.f + __expf(-g)) * up; }
                u32x4 w; w.x = cvt_pk_bf16(h[0], h[1]); w.y = cvt_pk_bf16(h[2], h[3]); w.z = cvt_pk_bf16(h[4], h[5]); w.w = cvt_pk_bf16(h[6], h[7]);
                *(u32x4*)rowp = w; }
    }
};
}

__device__ __forceinline__ void phase_ln(const float* Y, const float* __restrict__ gam, const float* __restrict__ bet, float* xo, bf16_t* __restrict__ xob) {
    const int wid = otid() >> 6, lane = otid() & 63;
    f32x4 gv[4], bv[4];
#pragma unroll
    for (int i = 0; i < 4; ++i) { gv[i] = *(const f32x4*)(gam + 4 * lane + 256 * i); bv[i] = *(const f32x4*)(bet + 4 * lane + 256 * i); }
    for (int row = blockIdx.x * 8 + wid; row < NT; row += gridDim.x * 8) {
        f32x4 v[4]; float s = 0.f;
#pragma unroll
        for (int i = 0; i < 4; ++i) { v[i] = *(const f32x4*)(Y + (size_t)row * DM + 4 * lane + 256 * i); s += (v[i][0] + v[i][1]) + (v[i][2] + v[i][3]); }
        for (int o = 32; o >= 1; o >>= 1) s += __shfl_xor(s, o);
        const float mu = s * (1.f / DM); float q = 0.f;
#pragma unroll
        for (int i = 0; i < 4; ++i) { const f32x4 d = v[i] - mu; q += (d[0] * d[0] + d[1] * d[1]) + (d[2] * d[2] + d[3] * d[3]); }
        for (int o = 32; o >= 1; o >>= 1) q += __shfl_xor(q, o);
        const float rs = rsqrtf(q * (1.f / DM) + LN_EPS);
#pragma unroll
        for (int i = 0; i < 4; ++i) { const f32x4 r = (v[i] - mu) * rs * gv[i] + bv[i]; *(f32x4*)(xo + (size_t)row * DM + 4 * lane + 256 * i) = r;
            u32x2 w; w.x = cvt_pk_bf16(r[0], r[1]); w.y = cvt_pk_bf16(r[2], r[3]); *(u32x2*)(xob + (size_t)row * DM + 4 * lane + 256 * i) = w; }
    }
}

namespace pg8 {
struct EpiKVQ {
    static constexpr bool PERM = true;
    bf16_t *Kb, *Vb, *Qb; float* kmp; const float *cs, *sn;
    __device__ __forceinline__ void operator()(const f32x4 (&acc)[2][2][4][2], const Unit& u, int wr, int wc, int fr, int fq) const {
        const int b = u.pm >> 3, blk = u.pm & 7; const int s0 = blk * 256 + wr * 64 + fr;
        if (u.pn >= 4 && u.pn < 8) {
            const int pnp = u.pn - 4;
#pragma unroll
            for (int bj = 0; bj < 2; ++bj) { const int head = 2 * pnp + bj; bf16_t* base = Vb + ((size_t)(b * NH + head) * SEQ) * DH + wc * 32 + 8 * fq;
#pragma unroll
                for (int ai = 0; ai < 2; ++ai)
#pragma unroll
                    for (int m = 0; m < 4; ++m) { int s = s0 + ai * HALF + m * 16; asm volatile("" : "+v"(s)); const f32x4 v0 = acc[ai][bj][m][0], v1 = acc[ai][bj][m][1];
                        u32x4 w; w.x = cvt_pk_bf16(v0[0], v0[1]); w.y = cvt_pk_bf16(v0[2], v0[3]); w.z = cvt_pk_bf16(v1[0], v1[1]); w.w = cvt_pk_bf16(v1[2], v1[3]);
                        *(u32x4*)(base + (size_t)s * DH) = w; } }
            return;
        }
        const bool isK = u.pn < 4; const int pnp = isK ? u.pn : u.pn - 8;
        const int head = 2 * pnp + (wc >> 1), f0 = 32 * (wc & 1) + 8 * fq;
        bf16_t* base = (isK ? Kb : Qb) + ((size_t)(b * NH + head) * SEQ) * DH + f0;
        float cs1[8], cs2[8];
#pragma unroll
        for (int j = 0; j < 8; ++j) { cs1[j] = 0.f; cs2[j] = 0.f; }
#pragma unroll
        for (int ai = 0; ai < 2; ++ai)
#pragma unroll
            for (int m = 0; m < 4; ++m) { int s = s0 + ai * HALF + m * 16; asm volatile("" : "+v"(s));
                const f32x4 c0 = *(const f32x4*)(cs + s * 64 + f0), c1 = *(const f32x4*)(cs + s * 64 + f0 + 4), n0 = *(const f32x4*)(sn + s * 64 + f0), n1 = *(const f32x4*)(sn + s * 64 + f0 + 4);
                const f32x4 a0 = acc[ai][0][m][0], a1 = acc[ai][0][m][1], b0 = acc[ai][1][m][0], b1 = acc[ai][1][m][1];
                const f32x4 o10 = a0 * c0 - b0 * n0, o11 = a1 * c1 - b1 * n1, o20 = b0 * c0 + a0 * n0, o21 = b1 * c1 + a1 * n1;
                u32x4 w1, w2; w1.x = cvt_pk_bf16(o10[0], o10[1]); w1.y = cvt_pk_bf16(o10[2], o10[3]); w1.z = cvt_pk_bf16(o11[0], o11[1]); w1.w = cvt_pk_bf16(o11[2], o11[3]);
                w2.x = cvt_pk_bf16(o20[0], o20[1]); w2.y = cvt_pk_bf16(o20[2], o20[3]); w2.z = cvt_pk_bf16(o21[0], o21[1]); w2.w = cvt_pk_bf16(o21[2], o21[3]);
                *(u32x4*)(base + (size_t)s * DH) = w1; *(u32x4*)(base + (size_t)s * DH + 64) = w2;
#pragma unroll
                for (int j = 0; j < 4; ++j) { cs1[j] += o10[j]; cs1[4 + j] += o11[j]; cs2[j] += o20[j]; cs2[4 + j] += o21[j]; }
                asm volatile("" : "+v"(cs1[0]), "+v"(cs1[1]), "+v"(cs1[2]), "+v"(cs1[3]), "+v"(cs1[4]), "+v"(cs1[5]), "+v"(cs1[6]), "+v"(cs1[7]),
                                  "+v"(cs2[0]), "+v"(cs2[1]), "+v"(cs2[2]), "+v"(cs2[3]), "+v"(cs2[4]), "+v"(cs2[5]), "+v"(cs2[6]), "+v"(cs2[7]) :: "memory"); }
        if (isK) {
#pragma unroll
            for (int j = 0; j < 8; ++j) {
#pragma unroll
                for (int o = 1; o <= 8; o <<= 1) { cs1[j] += __shfl_xor(cs1[j], o); cs2[j] += __shfl_xor(cs2[j], o); } }
            if (fr == 0) { float* kp = kmp + ((size_t)((b * NH + head) * 8 + blk) * 2 + wr) * 128 + f0;
                *(f32x4*)kp = (f32x4){cs1[0], cs1[1], cs1[2], cs1[3]}; *(f32x4*)(kp + 4) = (f32x4){cs1[4], cs1[5], cs1[6], cs1[7]};
                *(f32x4*)(kp + 64) = (f32x4){cs2[0], cs2[1], cs2[2], cs2[3]}; *(f32x4*)(kp + 68) = (f32x4){cs2[4], cs2[5], cs2[6], cs2[7]}; }
        }
    }
};
}

__device__ __forceinline__ void phase_ln_router(LAS unsigned char* lds, const float* Y, const float* __restrict__ gam, const float* __restrict__ bet, const float* __restrict__ wrt,
                                                float* xo, bf16_t* __restrict__ xob, int* __restrict__ te, float* __restrict__ tg, int* __restrict__ pos_of, int* gcnt, int* __restrict__ tok_of_slot) {
    LAS float* wl = (LAS float*)lds;
    LAS int* lcnt = (LAS int*)(lds + 32768);
    LAS int* ent = (LAS int*)(lds + 32768 + 64);
    const int tid = otid(), wid = tid >> 6, lane = tid & 63;
    for (int i = tid; i < 1024 * 8; i += NTHR) wl[i] = wrt[i];
    if (tid < 16) lcnt[tid] = 0;
    for (int i = blockIdx.x * NTHR + tid; i < MAXSLOT; i += gridDim.x * NTHR) tok_of_slot[i] = -1;
    __syncthreads();
    f32x4 gv[4], bv[4];
#pragma unroll
    for (int i = 0; i < 4; ++i) { gv[i] = *(const f32x4*)(gam + 4 * lane + 256 * i); bv[i] = *(const f32x4*)(bet + 4 * lane + 256 * i); }
    int kk = 0;
    for (int row = blockIdx.x * 8 + wid; row < NT; row += gridDim.x * 8, ++kk) {
        f32x4 v[4]; float s = 0.f;
#pragma unroll
        for (int i = 0; i < 4; ++i) { v[i] = *(const f32x4*)(Y + (size_t)row * DM + 4 * lane + 256 * i); s += (v[i][0] + v[i][1]) + (v[i][2] + v[i][3]); }
        for (int o = 32; o >= 1; o >>= 1) s += __shfl_xor(s, o);
        const float mu = s * (1.f / DM); float q = 0.f;
#pragma unroll
        for (int i = 0; i < 4; ++i) { const f32x4 d = v[i] - mu; q += (d[0] * d[0] + d[1] * d[1]) + (d[2] * d[2] + d[3] * d[3]); }
        for (int o = 32; o >= 1; o >>= 1) q += __shfl_xor(q, o);
        const float rs = rsqrtf(q * (1.f / DM) + LN_EPS);
        float lg[8];
#pragma unroll
        for (int e = 0; e < 8; ++e) lg[e] = 0.f;
#pragma unroll
        for (int i = 0; i < 4; ++i) { const f32x4 r = (v[i] - mu) * rs * gv[i] + bv[i]; *(f32x4*)(xo + (size_t)row * DM + 4 * lane + 256 * i) = r;
            u32x2 w; w.x = cvt_pk_bf16(r[0], r[1]); w.y = cvt_pk_bf16(r[2], r[3]); *(u32x2*)(xob + (size_t)row * DM + 4 * lane + 256 * i) = w;
#pragma unroll
            for (int j = 0; j < 4; ++j) { const int c = 4 * lane + 256 * i + j; const f32x4 w0 = *(const LAS f32x4*)(wl + c * 8), w1 = *(const LAS f32x4*)(wl + c * 8 + 4);
                lg[0] += r[j] * w0[0]; lg[1] += r[j] * w0[1]; lg[2] += r[j] * w0[2]; lg[3] += r[j] * w0[3]; lg[4] += r[j] * w1[0]; lg[5] += r[j] * w1[1]; lg[6] += r[j] * w1[2]; lg[7] += r[j] * w1[3]; } }
#pragma unroll
        for (int e = 0; e < 8; ++e) { float a = lg[e]; for (int o = 32; o >= 1; o >>= 1) a += __shfl_xor(a, o); lg[e] = a; }
        if (lane == 0) {
            float mx = lg[0];
#pragma unroll
            for (int e = 1; e < 8; ++e) mx = fmaxf(mx, lg[e]);
            float pr[8];
#pragma unroll
            for (int e = 0; e < 8; ++e) pr[e] = expf(lg[e] - mx);
            int e1 = 0; float p1 = pr[0];
#pragma unroll
            for (int e = 1; e < 8; ++e) if (pr[e] > p1) { p1 = pr[e]; e1 = e; }
            int e2 = -1; float p2 = -1.f;
#pragma unroll
            for (int e = 0; e < 8; ++e) if (e != e1 && pr[e] > p2) { p2 = pr[e]; e2 = e; }
            te[row * 2] = e1; te[row * 2 + 1] = e2; tg[row * 2] = p1 / (p1 + p2); tg[row * 2 + 1] = p2 / (p1 + p2);
            const int l1 = atomicAdd((int*)&lcnt[e1], 1), l2 = atomicAdd((int*)&lcnt[e2], 1);
            ent[(kk * 8 + wid) * 2] = e1 | (l1 << 8); ent[(kk * 8 + wid) * 2 + 1] = e2 | (l2 << 8);
        }
    }
    __syncthreads();
    if (tid < 8) lcnt[8 + tid] = atomicAdd(&gcnt[tid], lcnt[tid]);
    __syncthreads();
    if (tid < 128) { const int k2 = tid >> 1, kq = k2 >> 3, w8 = k2 & 7; const int row = blockIdx.x * 8 + w8 + kq * (int)gridDim.x * 8;
        if (row < NT) { const int en = ent[tid]; pos_of[row * 2 + (tid & 1)] = lcnt[8 + (en & 255)] + (en >> 8); } }
    __syncthreads();
}
__device__ __forceinline__ void moe_offsets(const int* gcnt, int (&off)[9]) { int o = 0;
#pragma unroll
    for (int e = 0; e < 8; ++e) { off[e] = o; o += ((gcnt[e] + 255) >> 8) << 8; } off[8] = o; }
__device__ __forceinline__ void phase_moe_map(const int* gcnt, const int* __restrict__ te, const float* __restrict__ tg, const int* __restrict__ pos_of, int* __restrict__ tok_of_slot, float* __restrict__ gate_of_slot, int* __restrict__ slot_of) {
    int off[9]; moe_offsets(gcnt, off);
    for (int i = blockIdx.x * NTHR + otid(); i < NT * 2; i += gridDim.x * NTHR) { const int e = te[i]; int ob = 0;
#pragma unroll
        for (int q = 0; q < 8; ++q) ob = (e == q) ? off[q] : ob;
        const int sl = ob + pos_of[i]; tok_of_slot[sl] = i >> 1; gate_of_slot[sl] = tg[i]; slot_of[i] = sl; }
}
namespace pg8 {
struct MoeSched {
    const char* A; const char* Bt; int off[9]; int rt0, rt1, nN, G, c, gather; size_t tstepA, tstepB, estride;
    __device__ __forceinline__ bool next(int i, Unit& u) const {
        int pm, pn; if (!tile_order((long)i * G + c, rt1 - rt0, nN, pm, pn)) return false;
        const int rt = rt0 + pm; int e = 0;
#pragma unroll
        for (int q = 1; q < 8; ++q) e = (rt * 256 >= off[q]) ? q : e;
        u.pm = rt; u.pn = pn; u.arow = rt * 256; u.pad = 0; u.A = gather ? A : A + (size_t)pm * tstepA; u.B = Bt + (size_t)e * estride + (size_t)pn * tstepB; return true;
    }
};
struct EpiMoeDown {
    static constexpr bool PERM = true;
    bf16_t* Ys; const float* gate;
    __device__ __forceinline__ void operator()(const f32x4 (&acc)[2][2][4][2], const Unit& u, int wr, int wc, int fr, int fq) const {
        const int row0 = u.pm * BM + wr * 64 + fr, col0 = u.pn * BM + wc * 32 + 8 * fq;
#pragma unroll
        for (int ai = 0; ai < 2; ++ai)
#pragma unroll
            for (int m = 0; m < 4; ++m) { const int row = row0 + ai * HALF + m * 16; const float gt = gate[row]; bf16_t* rowp = Ys + (size_t)row * DM + col0;
#pragma unroll
                for (int bj = 0; bj < 2; ++bj) { const f32x4 v0 = acc[ai][bj][m][0] * gt, v1 = acc[ai][bj][m][1] * gt;
                    u32x4 w; w.x = cvt_pk_bf16(v0[0], v0[1]); w.y = cvt_pk_bf16(v0[2], v0[3]); w.z = cvt_pk_bf16(v1[0], v1[1]); w.w = cvt_pk_bf16(v1[2], v1[3]);
                    *(u32x4*)(rowp + bj * HALF) = w; } }
    }
};
}
__device__ __forceinline__ void phase_final(const float* x3, const bf16_t* __restrict__ ys, const int* __restrict__ slot_of, const float* __restrict__ gam, const float* __restrict__ bet, float* out) {
    const int wid = otid() >> 6, lane = otid() & 63;
    f32x4 gv[4], bv[4];
#pragma unroll
    for (int i = 0; i < 4; ++i) { gv[i] = *(const f32x4*)(gam + 4 * lane + 256 * i); bv[i] = *(const f32x4*)(bet + 4 * lane + 256 * i); }
    for (int row = blockIdx.x * 8 + wid; row < NT; row += gridDim.x * 8) {
        const int s1 = slot_of[row * 2], s2 = slot_of[row * 2 + 1];
        f32x4 v[4]; float s = 0.f;
#pragma unroll
        for (int i = 0; i < 4; ++i) { const int c = 4 * lane + 256 * i; const f32x4 xv = *(const f32x4*)(x3 + (size_t)row * DM + c);
            const u32x2 a = *(const u32x2*)(ys + (size_t)s1 * DM + c), b = *(const u32x2*)(ys + (size_t)s2 * DM + c);
            f32x4 y; y[0] = bflo(a.x) + bflo(b.x); y[1] = bfhi(a.x) + bfhi(b.x); y[2] = bflo(a.y) + bflo(b.y); y[3] = bfhi(a.y) + bfhi(b.y);
            v[i] = xv * ALPHA + y; s += (v[i][0] + v[i][1]) + (v[i][2] + v[i][3]); }
        for (int o = 32; o >= 1; o >>= 1) s += __shfl_xor(s, o);
        const float mu = s * (1.f / DM); float q = 0.f;
#pragma unroll
        for (int i = 0; i < 4; ++i) { const f32x4 d = v[i] - mu; q += (d[0] * d[0] + d[1] * d[1]) + (d[2] * d[2] + d[3] * d[3]); }
        for (int o = 32; o >= 1; o >>= 1) q += __shfl_xor(q, o);
        const float rs = rsqrtf(q * (1.f / DM) + LN_EPS);
#pragma unroll
        for (int i = 0; i < 4; ++i) *(f32x4*)(out + (size_t)row * DM + 4 * lane + 256 * i) = (v[i] - mu) * rs * gv[i] + bv[i];
    }
}
namespace attn {
constexpr int D = 128;
constexpr float THR = 8.f;
constexpr bool WSKIP = false;
constexpr float SCALE = 0.08838834764831845f;
constexpr int NW = 8, QBLK = 32, KVBLK = 64, QB = NW * QBLK;
constexpr int SHM_V = KVBLK * D * 2, SHM_K = KVBLK * D * 2;
constexpr int LDS_KM = 2 * SHM_V + 2 * SHM_K + NW * 64 * 4;
constexpr int OSTR = 1024;
typedef short s16x4 __attribute__((ext_vector_type(4)));
typedef float f32x16 __attribute__((ext_vector_type(16)));
template <class A, class Bt> struct same_t { static constexpr bool v = false; };
template <class A> struct same_t<A, A> { static constexpr bool v = true; };
#define KSWZ(row, colB) ((row) * 256 + ((colB) ^ (((row) & 7) << 4)))
#define SBAR() __builtin_amdgcn_sched_barrier(0)
__device__ __forceinline__ int v_st(int k, int c) { const int kk = (k & ~0xC) | ((k & 4) << 1) | ((k & 8) >> 1); return ((kk >> 3) * 4 + (c >> 5)) * 512 + ((kk & 7) * 32 + (c & 31)) * 2; }
__device__ __forceinline__ int v_rd_base(int lane) { return ((lane & 3) << 3) | (((lane >> 2) & 3) << 6) | (((lane >> 4) & 1) << 5) | (((lane >> 5) & 1) << 8); }
constexpr int v_rd_off(int d0, int ks, int half) { return d0 * 512 + ks * 4096 + half * 2048; }
__device__ __forceinline__ int crow(int r, int hi) { return (r & 3) + 8 * (r >> 2) + 4 * hi; }
__device__ __forceinline__ unsigned cvtpk(float lo, float hi) {
    unsigned r; asm volatile("v_cvt_pk_bf16_f32 %0, %1, %2" : "=v"(r) : "v"(lo), "v"(hi)); return r;
}
__device__ __forceinline__ bf16x8 pack8(f32x4 a, f32x4 b) {
    u32x4 w = {cvtpk(a[0], a[1]), cvtpk(a[2], a[3]), cvtpk(b[0], b[1]), cvtpk(b[2], b[3])};
    return *reinterpret_cast<bf16x8*>(&w);
}
template <class T> __device__ __forceinline__ bf16x8 load8(const T* p) {
    if constexpr (same_t<T, float>::v) { return pack8(*(const f32x4*)p, *(const f32x4*)(p + 4)); }
    else { return *reinterpret_cast<const bf16x8*>(p); }
}
__device__ __forceinline__ void mask_tile(f32x16& p0, f32x16& p1, int dq, unsigned W) {
    const float NEG = -__builtin_inff();
#pragma unroll
    for (int r = 0; r < 16; ++r) {
        const int c = (r & 3) + 8 * (r >> 2);
        if ((unsigned)(dq - c) >= W) p0[r] = NEG;
        if ((unsigned)(dq - c - 32) >= W) p1[r] = NEG;
    }
}
__device__ __forceinline__ void partialSM(f32x16& p0, f32x16& p1, float& m_reg, float& mn, float& alpha) {
    float pmax = p0[0]; for (int r = 1; r < 16; ++r) pmax = fmaxf(pmax, p0[r]); for (int r = 0; r < 16; ++r) pmax = fmaxf(pmax, p1[r]);
    { auto rr = __builtin_amdgcn_permlane32_swap(__float_as_uint(pmax), __float_as_uint(pmax), false, false);
      pmax = fmaxf(__uint_as_float(rr[0]), __uint_as_float(rr[1])); }
    constexpr float C2 = 1.4426950408889634f * SCALE;
    if (__builtin_expect(__all((pmax - m_reg) * SCALE <= THR), 1)) { mn = m_reg; alpha = 1.f; }
    else { mn = fmaxf(m_reg, pmax); alpha = __builtin_amdgcn_exp2f((m_reg - mn) * C2); m_reg = mn; }
    const float mnL = -mn * C2;
    for (int r = 0; r < 16; ++r) p0[r] = fmaf(p0[r], C2, mnL); for (int r = 0; r < 16; ++r) p1[r] = fmaf(p1[r], C2, mnL);
    for (int r = 0; r < 16; ++r) p0[r] = __builtin_amdgcn_exp2f(p0[r]);
}
__device__ __forceinline__ void finishSM(f32x16& p0, f32x16& p1, float alpha, float& l_reg, bf16x8& pa0, bf16x8& pa1, bf16x8& pa2, bf16x8& pa3) {
    for (int r = 0; r < 16; ++r) p1[r] = __builtin_amdgcn_exp2f(p1[r]);
    float ps = 0; for (int r = 0; r < 16; ++r) ps += p0[r]; for (int r = 0; r < 16; ++r) ps += p1[r];
    { auto rr = __builtin_amdgcn_permlane32_swap(__float_as_uint(ps), __float_as_uint(ps), false, false);
      ps = __uint_as_float(rr[0]) + __uint_as_float(rr[1]); }
    l_reg = l_reg * alpha + ps;
#define PK4(P, B_, OUT) do { unsigned a0 = cvtpk(P[B_+0], P[B_+1]), a1 = cvtpk(P[B_+2], P[B_+3]);                          \
        unsigned b0 = cvtpk(P[B_+4], P[B_+5]), b1 = cvtpk(P[B_+6], P[B_+7]);                                             \
        auto r0 = __builtin_amdgcn_permlane32_swap(a0, b0, false, false); auto r1 = __builtin_amdgcn_permlane32_swap(a1, b1, false, false); \
        u32x4 w = {r0[0], r1[0], r0[1], r1[1]}; OUT = *reinterpret_cast<bf16x8*>(&w); } while (0)
    PK4(p0, 0, pa0); PK4(p0, 8, pa1); PK4(p1, 0, pa2); PK4(p1, 8, pa3);
#undef PK4
}
template <int KB, bool SK>
__device__ __forceinline__ void qkt(f32x16& p0, f32x16& p1, const char* K_lds, int r32, int hi, const bf16x8* qr, bool act) {
    if (SK && !act) { const float NEG = -__builtin_inff();
#pragma unroll
        for (int r = 0; r < 16; ++r) { p0[r] = NEG; p1[r] = NEG; } return; }
    p0 = f32x16{}; p1 = f32x16{};
    const char* kb[4];
#pragma unroll
    for (int dd = 0; dd < 4; ++dd) kb[dd] = K_lds + KB * SHM_K + KSWZ(r32, (dd * 16 + hi * 8) * 2);
#pragma unroll
    for (int d0 = 0; d0 < 8; ++d0) { const char* a = kb[d0 & 3] + (d0 >> 2) * 128;
        bf16x8 b0 = *reinterpret_cast<const bf16x8*>(a);
        bf16x8 b1 = *reinterpret_cast<const bf16x8*>(a + 32 * 256);
        p0 = __builtin_amdgcn_mfma_f32_32x32x16_bf16(b0, qr[d0], p0, 0, 0, 0);
        p1 = __builtin_amdgcn_mfma_f32_32x32x16_bf16(b1, qr[d0], p1, 0, 0, 0); }
}
template <int VB, bool SK>
__device__ __forceinline__ void pv_tile(f32x16* o, int vb0, bf16x8 pa0, bf16x8 pa1, bf16x8 pa2, bf16x8 pa3, bool act) {
    if (SK && !act) return;
#define TRRD(dst, off) asm volatile("ds_read_b64_tr_b16 %0, %1 offset:%2" : "=&v"(dst) : "v"(vb0), "i"(off) : "memory")
#define PV_D0(d0) do { s16x4 l0, l1, l2, l3, h0, h1, h2, h3; constexpr int b_ = VB * SHM_V + v_rd_off(d0, 0, 0);     \
        TRRD(l0, b_); TRRD(h0, b_ + 2048); TRRD(l1, b_ + 4096); TRRD(h1, b_ + 6144); TRRD(l2, b_ + 8192); TRRD(h2, b_ + 10240); TRRD(l3, b_ + 12288); TRRD(h3, b_ + 14336); \
        asm volatile("s_waitcnt lgkmcnt(0)" ::: "memory"); SBAR();                 \
        o[d0] = __builtin_amdgcn_mfma_f32_32x32x16_bf16(pa0, (bf16x8){l0[0], l0[1], l0[2], l0[3], h0[0], h0[1], h0[2], h0[3]}, o[d0], 0, 0, 0);   \
        o[d0] = __builtin_amdgcn_mfma_f32_32x32x16_bf16(pa1, (bf16x8){l1[0], l1[1], l1[2], l1[3], h1[0], h1[1], h1[2], h1[3]}, o[d0], 0, 0, 0);   \
        o[d0] = __builtin_amdgcn_mfma_f32_32x32x16_bf16(pa2, (bf16x8){l2[0], l2[1], l2[2], l2[3], h2[0], h2[1], h2[2], h2[3]}, o[d0], 0, 0, 0);   \
        o[d0] = __builtin_amdgcn_mfma_f32_32x32x16_bf16(pa3, (bf16x8){l3[0], l3[1], l3[2], l3[3], h3[0], h3[1], h3[2], h3[3]}, o[d0], 0, 0, 0); } while (0)
    PV_D0(0); PV_D0(1); PV_D0(2); PV_D0(3);
#undef PV_D0
#undef TRRD
}

template <class TIn, class TOut> struct BlockRef { const TIn* Q; const TIn* K; const TIn* V; TOut* O; const float* KM; int P0; int pad; };
template <class TIn> struct Seam {
    bf16x8 qr[8];
    bf16x8 st_v0, st_v1, st_k0, st_k1; f32x4 sf0, sf1, sf2, sf3;
    f32x4 tq[16];
};
__device__ __forceinline__ int swa_jlo(int P0, int W) { const int lowk = P0 - W + 1; return lowk > 0 ? lowk / KVBLK : 0; }
#define ROW(p, k0, rr) ((p) + (size_t)((k0) + (rr)) * D + sc)
#define VMW() asm volatile("s_waitcnt vmcnt(0)" ::: "memory")
#define VMWN(n) asm volatile("s_waitcnt vmcnt(%0)" :: "i"(n) : "memory")
#define SLOAD_H(Kp, Vp, k0) do { S.st_v0 = load8<TIn>(ROW(Vp, k0, sr)); S.st_v1 = load8<TIn>(ROW(Vp, k0, 32 + sr));              \
                         S.st_k0 = load8<TIn>(ROW(Kp, k0, sr)); S.st_k1 = load8<TIn>(ROW(Kp, k0, 32 + sr)); } while (0)
#define SWRITE_HK(bf) do { *(bf16x8*)(K_lds + (bf) * SHM_K + kws) = S.st_k0; *(bf16x8*)(K_lds + (bf) * SHM_K + kws + 32 * 256) = S.st_k1; } while (0)
#define SWRITE_HV(bf) do { *(bf16x8*)(V_lds + (bf) * SHM_V + vst0) = S.st_v0; *(bf16x8*)(V_lds + (bf) * SHM_V + vst1) = S.st_v1; } while (0)
#define SWRITE_H(bf) do { SWRITE_HV(bf); SWRITE_HK(bf); } while (0)
#define SLOAD_F(p, k0) do { S.sf0 = *(const f32x4*)ROW(p, k0, sr); S.sf1 = *(const f32x4*)(ROW(p, k0, sr) + 4);                \
                            S.sf2 = *(const f32x4*)ROW(p, k0, 32 + sr); S.sf3 = *(const f32x4*)(ROW(p, k0, 32 + sr) + 4); } while (0)
#define SWRITE_KF(bf) do { *(bf16x8*)(K_lds + (bf) * SHM_K + kws) = pack8(S.sf0, S.sf1); *(bf16x8*)(K_lds + (bf) * SHM_K + kws + 32 * 256) = pack8(S.sf2, S.sf3); } while (0)
#define SWRITE_VF(bf) do { *(bf16x8*)(V_lds + (bf) * SHM_V + vst0) = pack8(S.sf0, S.sf1); *(bf16x8*)(V_lds + (bf) * SHM_V + vst1) = pack8(S.sf2, S.sf3); } while (0)
template <class TIn, class TOut>
__device__ __forceinline__ void causal_swa_prime(const BlockRef<TIn, TOut>& cur, int W, char* lds, Seam<TIn>& S) {
    constexpr bool F32 = same_t<TIn, float>::v;
    const int tid = otid(), wid = __builtin_amdgcn_readfirstlane(tid >> 6), lane = tid & 63, r32 = lane & 31, hi = lane >> 5;
    const int sr = tid >> 4, sc = (tid & 15) * 8, kws = KSWZ(sr, sc * 2); char* K_lds = lds + 2 * SHM_V;
    const int kb0 = swa_jlo(cur.P0, W) * KVBLK;
    for (int d0 = 0; d0 < 8; ++d0) S.qr[d0] = load8<TIn>(cur.Q + (size_t)(wid * QBLK + r32) * D + d0 * 16 + hi * 8);
    if constexpr (F32) { SLOAD_F((const float*)cur.K, kb0); VMW(); SWRITE_KF(0); SBAR(); SLOAD_F((const float*)cur.V, kb0); }
    else { SLOAD_H(cur.K, cur.V, kb0); VMW(); SWRITE_HK(0); }
    __syncthreads();
}
template <class TIn, class TOut>
__device__ __forceinline__ void causal_swa_block(const BlockRef<TIn, TOut>& cur, const BlockRef<TIn, TOut>& nxt, int skv, int W, char* lds, Seam<TIn>& S) {
    constexpr bool F32 = same_t<TIn, float>::v;
    const int tid = otid(), wid = __builtin_amdgcn_readfirstlane(tid >> 6), lane = tid & 63, r32 = lane & 31, hi = lane >> 5;
    const int j_lo = swa_jlo(cur.P0, W);
    int j_hi = (cur.P0 + QB - 1) / KVBLK + 1; if (j_hi > skv / KVBLK) j_hi = skv / KVBLK;
    const int NT = j_hi - j_lo;
    const int kbn = swa_jlo(nxt.P0, W) * KVBLK;
    const int qlo = cur.P0 + wid * QBLK, qm = qlo + r32 - 4 * hi;
    char* V_lds = lds; char* K_lds = lds + 2 * SHM_V;
    float* ws = (float*)(lds + 2 * SHM_V + 2 * SHM_K) + wid * 64; float* li_l = ws, * al_l = ws + 32;
    float m_reg = -1e30f, l_reg = 0; f32x16 o[4] = {};
    const int sr = tid >> 4, sc = (tid & 15) * 8, vst0 = v_st(sr, sc), vst1 = v_st(32 + sr, sc), kws = KSWZ(sr, sc * 2);
    const int vb0 = (int)(uintptr_t)V_lds + v_rd_base(lane);
    const TIn* Kh = cur.K; const TIn* Vh = cur.V;
    const int qblk = cur.P0 >> 8; unsigned selmask = 0u;
    {
        float* kml = (float*)(lds + LDS_KM);
        for (int i = tid; i < 8 * 128; i += 512) { const int n = i >> 7, d = i & 127; kml[i] = (cur.KM[(n * 2 + 0) * 128 + d] + cur.KM[(n * 2 + 1) * 128 + d]) * (1.f / 256.f); }
        __syncthreads();
        float gs[8];
#pragma unroll
        for (int n = 0; n < 8; ++n) gs[n] = -3.0e38f;
#pragma unroll
        for (int n = 0; n < 7; ++n) if (n < qblk) { float a = 0.f;
#pragma unroll
            for (int d0 = 0; d0 < 8; ++d0) { const f32x4 k0 = *(const f32x4*)(kml + n * 128 + d0 * 16 + hi * 8), k1 = *(const f32x4*)(kml + n * 128 + d0 * 16 + hi * 8 + 4); const bf16x8 qv = S.qr[d0];
                a += __uint_as_float(((unsigned)(unsigned short)qv[0]) << 16) * k0[0] + __uint_as_float(((unsigned)(unsigned short)qv[1]) << 16) * k0[1]
                   + __uint_as_float(((unsigned)(unsigned short)qv[2]) << 16) * k0[2] + __uint_as_float(((unsigned)(unsigned short)qv[3]) << 16) * k0[3]
                   + __uint_as_float(((unsigned)(unsigned short)qv[4]) << 16) * k1[0] + __uint_as_float(((unsigned)(unsigned short)qv[5]) << 16) * k1[1]
                   + __uint_as_float(((unsigned)(unsigned short)qv[6]) << 16) * k1[2] + __uint_as_float(((unsigned)(unsigned short)qv[7]) << 16) * k1[3]; }
            a += __shfl_xor(a, 32); gs[n] = a; }
        if (qblk <= 3) selmask = (1u << qblk) - 1u;
        else {
#pragma unroll
            for (int r = 0; r < 3; ++r) { float bv = -3.0e38f; int best = 0;
#pragma unroll
                for (int n = 0; n < 7; ++n) { const bool ok = (n < qblk) && (((selmask >> n) & 1u) == 0u) && (gs[n] > bv); bv = ok ? gs[n] : bv; best = ok ? n : best; }
                selmask |= 1u << best; }
        }
    }
#define RESC(a) do { if (__any((a) < 1.f)) { if (hi == 0) al_l[r32] = (a); asm volatile("s_waitcnt lgkmcnt(0)" ::: "memory");              \
                     for (int d_ = 0; d_ < 4; ++d_) for (int r = 0; r < 16; ++r) o[d_][r] *= al_l[crow(r, hi)]; } } while (0)
#define KBASE(t) ((j_lo + (t)) * KVBLK)
#define ACT(t) (KBASE(t) <= qlo + QBLK - 1 && KBASE(t) + KVBLK - 1 >= qlo - W + 1)
#define MASKT(P0_, P1_, t) do { const int kb_ = KBASE(t); if ((!SK || ACT(t)) && (kb_ + KVBLK - 1 > qlo || kb_ <= qlo + QBLK - 1 - W)) mask_tile(P0_, P1_, qm - kb_, (unsigned)W); \
        const int nb_ = kb_ >> 8; if (nb_ < qblk) { const bool drop_ = ((selmask >> nb_) & 1u) == 0u; const float NEG_ = -__builtin_inff(); \
            _Pragma("unroll") for (int r_ = 0; r_ < 16; ++r_) { P0_[r_] = drop_ ? NEG_ : P0_[r_]; P1_[r_] = drop_ ? NEG_ : P1_[r_]; } } } while (0)
    constexpr int NQL = F32 ? 16 : 8;
    constexpr bool SK = WSKIP && !F32;
#define SEAM_K0() do { VMWN(NQL); if constexpr (F32) { SWRITE_KF(0); SBAR(); SLOAD_F((const float*)nxt.V, kbn); } else { SWRITE_HK(0); } SBAR(); } while (0)
    f32x16 pA0, pA1, pB0, pB1; float mnA, mnB, alA, alB; bf16x8 pa0, pa1, pa2, pa3;
    if constexpr (F32) { VMW(); SWRITE_VF(0); SBAR(); } else { SWRITE_HV(0); SBAR(); }
    if (NT > 1) { if constexpr (F32) SLOAD_F((const float*)Kh, KBASE(1)); else SLOAD_H(Kh, Vh, KBASE(1)); }
    SBAR(); qkt<0, SK>(pA0, pA1, K_lds, r32, hi, S.qr, ACT(0));
    if constexpr (F32) { if (NT > 1) { VMW(); SWRITE_KF(1); SBAR(); SLOAD_F((const float*)Vh, KBASE(1)); } }
    MASKT(pA0, pA1, 0); partialSM(pA0, pA1, m_reg, mnA, alA);
    if (NT > 1) { VMW(); if constexpr (F32) { SWRITE_VF(1); SBAR(); if (NT > 2) SLOAD_F((const float*)Kh, KBASE(2)); } else SWRITE_H(1); }
    __syncthreads();
#define HALF_STEP(PX0, PX1, mnX, alX, PY0, PY1, alY, t, KB, VB, SB) do {                                                      \
        SBAR(); qkt<KB, SK>(PX0, PX1, K_lds, r32, hi, S.qr, ACT(t));                                             \
        finishSM(PY0, PY1, alY, l_reg, pa0, pa1, pa2, pa3); SBAR();                                                           \
        if ((t) + 1 < NT) { if constexpr (F32) { VMW(); SWRITE_KF(SB); SBAR(); SLOAD_F((const float*)Vh, KBASE((t) + 1)); }  \
                            else { SLOAD_H(Kh, Vh, KBASE((t) + 1)); } SBAR(); }                                               \
        pv_tile<VB, SK>(o, vb0, pa0, pa1, pa2, pa3, ACT((t) - 1)); MASKT(PX0, PX1, (t)); partialSM(PX0, PX1, m_reg, mnX, alX);                                        \
        __syncthreads();                                                                                                      \
        if ((t) + 1 < NT) { VMW(); if constexpr (F32) { SWRITE_VF(SB); SBAR(); if ((t) + 2 < NT) SLOAD_F((const float*)Kh, KBASE((t) + 2)); } \
                            else { SWRITE_H(SB); } }                                                                          \
        RESC(alX); __syncthreads(); } while (0)
    for (int t = 1; t + 1 < NT; t += 2) {
        HALF_STEP(pB0, pB1, mnB, alB, pA0, pA1, alA, t, 1, 0, 0);
        HALF_STEP(pA0, pA1, mnA, alA, pB0, pB1, alB, t + 1, 0, 1, 1);
    }
    const bool even = (NT & 1) == 0;
    if (even) { SBAR(); qkt<1, SK>(pB0, pB1, K_lds, r32, hi, S.qr, ACT(NT - 1)); SBAR(); }
#define QROW(e) (nxt.Q + (size_t)(wid * QBLK + r32) * D + ((e) >> 1) * 16 + hi * 8 + ((e) & 1) * 4)
    if constexpr (F32) { SLOAD_F((const float*)nxt.K, kbn); SBAR();
#pragma unroll
        for (int e = 0; e < 8; ++e) S.tq[e] = *(const f32x4*)QROW(e); }
    else { SLOAD_H(nxt.K, nxt.V, kbn); SBAR();
#pragma unroll
        for (int d0 = 0; d0 < 8; ++d0) S.qr[d0] = load8<TIn>(nxt.Q + (size_t)(wid * QBLK + r32) * D + d0 * 16 + hi * 8); }
    SBAR();
    finishSM(pA0, pA1, alA, l_reg, pa0, pa1, pa2, pa3); SBAR();
    if constexpr (F32) {
#pragma unroll
        for (int e = 8; e < 16; ++e) S.tq[e] = *(const f32x4*)QROW(e); SBAR(); }
#undef QROW
    pv_tile<0, SK>(o, vb0, pa0, pa1, pa2, pa3, ACT(even ? NT - 2 : NT - 1));
    if (even) { MASKT(pB0, pB1, NT - 1); partialSM(pB0, pB1, m_reg, mnB, alB); __syncthreads(); RESC(alB);
        finishSM(pB0, pB1, alB, l_reg, pa0, pa1, pa2, pa3); SBAR(); pv_tile<1, SK>(o, vb0, pa0, pa1, pa2, pa3, ACT(NT - 1)); }
    SBAR(); SEAM_K0();
    if (hi == 0) li_l[r32] = l_reg; asm volatile("s_waitcnt lgkmcnt(0)" ::: "memory");
    float rli[16];
#pragma unroll
    for (int r = 0; r < 16; ++r) rli[r] = __builtin_amdgcn_rcpf(li_l[crow(r, hi)]);
    TOut* Ow = cur.O + (size_t)(wid * QBLK) * OSTR;
#pragma unroll
    for (int r = 0; r < 16; ++r) { const int orow = crow(r, hi);
#pragma unroll
        for (int d0 = 0; d0 < 4; ++d0) { const float v = o[d0][r] * rli[r];
            if constexpr (same_t<TOut, float>::v) { Ow[(size_t)orow * OSTR + d0 * 32 + r32] = v; }
            else { const float vn = __shfl_xor(v, 1);
                   if ((r32 & 1) == 0) *(unsigned*)(Ow + (size_t)orow * OSTR + d0 * 32 + r32) = cvtpk(v, vn); } } }
    if constexpr (F32) {
#pragma unroll
        for (int d0 = 0; d0 < 8; ++d0) S.qr[d0] = pack8(S.tq[2 * d0], S.tq[2 * d0 + 1]); }
    __syncthreads();
#undef RESC
#undef KBASE
#undef ACT
#undef MASKT
#undef SEAM_K0
#undef HALF_STEP
}
#undef ROW
#undef VMW
#undef VMWN
#undef SLOAD_H
#undef SWRITE_HK
#undef SWRITE_HV
#undef SWRITE_H
#undef SLOAD_F
#undef SWRITE_KF
#undef SWRITE_VF
}

__device__ __forceinline__ void phase_attn(LAS unsigned char* lds_, const bf16_t* __restrict__ Qb, const bf16_t* __restrict__ Kb, const bf16_t* __restrict__ Vb, const float* __restrict__ kmp, bf16_t* __restrict__ att) {
    using namespace attn;
    char* lds = (char*)lds_;
    typedef BlockRef<bf16_t, bf16_t> Ref;
    const int total = 256, stride = gridDim.x;
    int L = blockIdx.x; if (L >= total) return;
    auto mkref = [&](int Li, int pass) { const int bh = (Li & 7) + 8 * (Li >> 5), x = (Li >> 3) & 3; const int qb = pass ? 7 - x : x; const int b = bh >> 3, h = bh & 7;
        Ref r; r.Q = Qb + ((size_t)bh * SEQ + (size_t)qb * QB) * D; r.K = Kb + (size_t)bh * SEQ * D; r.V = Vb + (size_t)bh * SEQ * D;
        r.O = att + ((size_t)(b * SEQ + qb * QB) * OSTR + h * D); r.KM = kmp + (size_t)bh * 8 * 2 * 128; r.P0 = qb * QB; r.pad = 0; return r; };
    int pass = 0; Ref cur = mkref(L, 0);
    Seam<bf16_t> S;
    const int W = 0x7fffffff;
    causal_swa_prime<bf16_t, bf16_t>(cur, W, lds, S);
    for (;;) {
        const bool more_pass = pass == 0, more_item = L + stride < total, last = !more_pass && !more_item;
        int passn = pass + 1, Ln = L;
        if (!more_pass) { passn = 0; Ln = more_item ? L + stride : L; }
        const Ref nxt = last ? cur : mkref(Ln, passn);
        causal_swa_block<bf16_t, bf16_t>(cur, nxt, SEQ, W, lds, S);
        if (last) break;
        cur = nxt; pass = passn; L = Ln;
    }
}
template <int CTRL> __device__ __forceinline__ float dpp_mov(float x) { return __int_as_float(__builtin_amdgcn_update_dpp(0, __float_as_int(x), CTRL, 0xf, 0xf, false)); }
__device__ __forceinline__ float red16(float x) { x += dpp_mov<0x128>(x); x += dpp_mov<0x124>(x); x += dpp_mov<0x122>(x); x += dpp_mov<0x121>(x); return x; }

__device__ __forceinline__ void phase_dn(LAS unsigned char* lds, const bf16_t* __restrict__ proj, const float* __restrict__ convw, const float* __restrict__ gl, const float* __restrict__ betal, float* __restrict__ og) {
    LAS float* KQ = (LAS float*)lds;
    LAS float* VL = (LAS float*)(lds + 65536);
    LAS float* SC = (LAS float*)(lds + 73728);
    LAS float* OL = (LAS float*)(lds + 74752);
    const int tid = otid(), lane = tid & 63, wid = tid >> 6;
    for (int L = blockIdx.x; L < 256; L += gridDim.x) {
    const int bh = (L & 7) + 8 * (L >> 5), s4 = (L >> 3) & 3, b = bh >> 3, h = bh & 7;
    const int g = tid & 31, run = tid >> 5; const bool isq = g < 16;
    const int chqk = (isq ? 0 : 1024) + h * 128 + 8 * (g & 15);
    const int gv = tid & 3, tv = tid >> 2; const int chv = 2048 + h * 128 + 32 * s4 + 8 * gv;
    float wqk[4][8], wv[4][8];
#pragma unroll
    for (int j = 0; j < 4; ++j)
#pragma unroll
        for (int e = 0; e < 8; ++e) { wqk[j][e] = convw[j * 3072 + chqk + e]; wv[j][e] = convw[j * 3072 + chv + e]; }
    const size_t tok0 = (size_t)b * SEQ;
    u32x4 rq[7], rv[4];
    auto load_chunk = [&](int t0) {
#pragma unroll
        for (int i = 0; i < 7; ++i) { const int s = t0 + 4 * run - 3 + i; rq[i] = (s >= 0) ? *(const u32x4*)(proj + (tok0 + s) * 4096 + chqk) : (u32x4){0u, 0u, 0u, 0u}; }
        if (tid < 256) {
#pragma unroll
            for (int i = 0; i < 4; ++i) { const int s = t0 + tv - 3 + i; rv[i] = (s >= 0) ? *(const u32x4*)(proj + (tok0 + s) * 4096 + chv) : (u32x4){0u, 0u, 0u, 0u}; } }
    };
    auto unpack8 = [](const u32x4& w, float (&f)[8]) { f[0] = bflo(w.x); f[1] = bfhi(w.x); f[2] = bflo(w.y); f[3] = bfhi(w.y); f[4] = bflo(w.z); f[5] = bfhi(w.z); f[6] = bflo(w.w); f[7] = bfhi(w.w); };
    const int r = lane & 15, jc = wid * 4 + (lane >> 4);
    float St[8];
#pragma unroll
    for (int i = 0; i < 8; ++i) St[i] = 0.f;
    load_chunk(0);
    for (int n = 0; n < SEQ / 64; ++n) {
        const int t0 = n * 64;
        {
            float xr[7][8];
#pragma unroll
            for (int i = 0; i < 7; ++i) unpack8(rq[i], xr[i]);
#pragma unroll
            for (int u = 0; u < 4; ++u) { float y[8]; float ss = 0.f;
#pragma unroll
                for (int e = 0; e < 8; ++e) { float a = wqk[0][e] * xr[u][e]; a = fmaf(wqk[1][e], xr[u + 1][e], a); a = fmaf(wqk[2][e], xr[u + 2][e], a); a = fmaf(wqk[3][e], xr[u + 3][e], a);
                    y[e] = a * __builtin_amdgcn_rcpf(1.f + __expf(-a)); ss = fmaf(y[e], y[e], ss); }
                ss = red16(ss);
                const float sc = rsqrtf(ss + 1e-6f) * (isq ? 0.08838834764831845f : 1.f);
                const int t = 4 * run + u; LAS float* dst = KQ + t * 256 + (isq ? 128 : 0) + (g & 15) * 4;
                *(LAS f32x4*)dst = (f32x4){y[0] * sc, y[1] * sc, y[2] * sc, y[3] * sc}; *(LAS f32x4*)(dst + 64) = (f32x4){y[4] * sc, y[5] * sc, y[6] * sc, y[7] * sc}; }
            if (tid < 256) { float xv[4][8];
#pragma unroll
                for (int i = 0; i < 4; ++i) unpack8(rv[i], xv[i]);
                float y[8];
#pragma unroll
                for (int e = 0; e < 8; ++e) { float a = wv[0][e] * xv[0][e]; a = fmaf(wv[1][e], xv[1][e], a); a = fmaf(wv[2][e], xv[2][e], a); a = fmaf(wv[3][e], xv[3][e], a); y[e] = a * __builtin_amdgcn_rcpf(1.f + __expf(-a)); }
                *(LAS f32x4*)(VL + tv * 32 + 8 * gv) = (f32x4){y[0], y[1], y[2], y[3]}; *(LAS f32x4*)(VL + tv * 32 + 8 * gv + 4) = (f32x4){y[4], y[5], y[6], y[7]}; }
            else if (tid < 320) { const int t = tid - 256; const size_t ix = (tok0 + t0 + t) * 8 + h; SC[t * 4 + 0] = __expf(gl[ix]); SC[t * 4 + 1] = betal[ix]; }
        }
        __syncthreads();
        {
            const int t = tid >> 3, p8 = tid & 7; float a = 0.f;
#pragma unroll
            for (int rr = 0; rr < 2; ++rr)
#pragma unroll
                for (int pp = 0; pp < 2; ++pp) { const f32x4 kk = *(const LAS f32x4*)(KQ + t * 256 + pp * 64 + (2 * p8 + rr) * 4), qq = *(const LAS f32x4*)(KQ + t * 256 + 128 + pp * 64 + (2 * p8 + rr) * 4);
                    a += kk[0] * qq[0] + kk[1] * qq[1] + kk[2] * qq[2] + kk[3] * qq[3]; }
            a += __shfl_xor(a, 1); a += __shfl_xor(a, 2); a += __shfl_xor(a, 4);
            if (p8 == 0) SC[t * 4 + 2] = a;
        }
        __syncthreads();
        if (n + 1 < SEQ / 64) load_chunk(t0 + 64);
#pragma unroll 4
        for (int t = 0; t < 64; ++t) {
            const f32x4 k0 = *(const LAS f32x4*)(KQ + t * 256 + r * 4), k1 = *(const LAS f32x4*)(KQ + t * 256 + 64 + r * 4);
            const f32x4 q0 = *(const LAS f32x4*)(KQ + t * 256 + 128 + r * 4), q1 = *(const LAS f32x4*)(KQ + t * 256 + 192 + r * 4);
            const f32x4 sc = *(const LAS f32x4*)(SC + t * 4); const float vj = VL[t * 32 + jc];
            float kd = k0[0] * St[0], qd = q0[0] * St[0];
            kd = fmaf(k0[1], St[1], kd); qd = fmaf(q0[1], St[1], qd); kd = fmaf(k0[2], St[2], kd); qd = fmaf(q0[2], St[2], qd); kd = fmaf(k0[3], St[3], kd); qd = fmaf(q0[3], St[3], qd);
            kd = fmaf(k1[0], St[4], kd); qd = fmaf(q1[0], St[4], qd); kd = fmaf(k1[1], St[5], kd); qd = fmaf(q1[1], St[5], qd); kd = fmaf(k1[2], St[6], kd); qd = fmaf(q1[2], St[6], qd); kd = fmaf(k1[3], St[7], kd); qd = fmaf(q1[3], St[7], qd);
            kd = red16(kd); qd = red16(qd);
            const float eg = sc[0], vn = sc[1] * (vj - eg * kd);
            St[0] = fmaf(k0[0], vn, eg * St[0]); St[1] = fmaf(k0[1], vn, eg * St[1]); St[2] = fmaf(k0[2], vn, eg * St[2]); St[3] = fmaf(k0[3], vn, eg * St[3]);
            St[4] = fmaf(k1[0], vn, eg * St[4]); St[5] = fmaf(k1[1], vn, eg * St[5]); St[6] = fmaf(k1[2], vn, eg * St[6]); St[7] = fmaf(k1[3], vn, eg * St[7]);
            if (r == 0) OL[t * 32 + jc] = fmaf(eg, qd, sc[2] * vn);
        }
        __syncthreads();
        {
            const int t = tid >> 3, c4 = (tid & 7) * 4;
            *(f32x4*)(og + (tok0 + t0 + t) * DM + h * 128 + s4 * 32 + c4) = *(const LAS f32x4*)(OL + t * 32 + c4);
        }
    }
    __syncthreads();
    }
}
__device__ __forceinline__ void phase_dn_post(const float* __restrict__ o, const bf16_t* __restrict__ proj, const float* __restrict__ norm_w, bf16_t* __restrict__ ogb) {
    const int wid = otid() >> 6, lane = otid() & 63;
    const f32x4 nw = *(const f32x4*)(norm_w + ((4 * lane) & 127));
    for (int row = blockIdx.x * 8 + wid; row < NT; row += gridDim.x * 8) {
#pragma unroll
        for (int i = 0; i < 4; ++i) { const int c = 4 * lane + 256 * i; const f32x4 v = *(const f32x4*)(o + (size_t)row * DM + c);
            float ss = (v[0] * v[0] + v[1] * v[1]) + (v[2] * v[2] + v[3] * v[3]);
            ss += __shfl_xor(ss, 1); ss += __shfl_xor(ss, 2); ss += __shfl_xor(ss, 4); ss += __shfl_xor(ss, 8); ss += __shfl_xor(ss, 16);
            const float rr = rsqrtf(ss * (1.f / 128.f) + 1e-6f);
            const u32x2 gw = *(const u32x2*)(proj + (size_t)row * 4096 + 3072 + c);
            const float g0 = bflo(gw.x), g1 = bfhi(gw.x), g2 = bflo(gw.y), g3 = bfhi(gw.y);
            const float r0 = v[0] * rr * nw[0] * (g0 / (1.f + __expf(-g0))), r1 = v[1] * rr * nw[1] * (g1 / (1.f + __expf(-g1))), r2 = v[2] * rr * nw[2] * (g2 / (1.f + __expf(-g2))), r3 = v[3] * rr * nw[3] * (g3 / (1.f + __expf(-g3)));
            u32x2 w; w.x = cvt_pk_bf16(r0, r1); w.y = cvt_pk_bf16(r2, r3); *(u32x2*)(ogb + (size_t)row * DM + c) = w; }
    }
}
#define XB_TMO      128
#define XB_XCNT(j)  (256  + 64 * (j))
#define XB_XSUB(j)  (1280 + 64 * (j))
#define XB_XGEN(j)  (2304 + 64 * (j))
#define XB_TOP      3328
#define XB_TOPGEN   3392
#define XCD_BAR_WORDS 3456
#define XB_SPIN_CAP (1u << 18)

__device__ __forceinline__ unsigned xb_ld(unsigned* p)              { return __hip_atomic_load(p, __ATOMIC_RELAXED, __HIP_MEMORY_SCOPE_AGENT); }
__device__ __forceinline__ unsigned xb_add(unsigned* p, unsigned v) { return __hip_atomic_fetch_add(p, v, __ATOMIC_RELAXED, __HIP_MEMORY_SCOPE_AGENT); }
__device__ __forceinline__ unsigned xb_xcc_id() { return (unsigned)__builtin_amdgcn_s_getreg((3 << 11) | 20) & 0xFu; }
#define XB_SPIN(cond, bar) do { unsigned _sp = 0; while (cond) { __builtin_amdgcn_s_sleep(1); \
    if ((++_sp & 255u) == 0u) { if (xb_ld(&(bar)[XB_TMO])) break; if (_sp > XB_SPIN_CAP) { atomicAdd(&(bar)[XB_TMO], 1u); break; } } } } while (0)

struct XcdBarrier {
    unsigned* bar; unsigned x;
    volatile LAS unsigned* st;
};

__device__ __forceinline__ XcdBarrier xcd_barrier_post(unsigned* bar, volatile LAS unsigned* st) {
    XcdBarrier b; b.bar = bar; b.x = xb_xcc_id(); b.st = st;
    if (threadIdx.x == 0) (void)xb_add(&bar[XB_XCNT(b.x)], 1u);
    return b;
}
__device__ __forceinline__ void xcd_barrier_complete(unsigned* bar, unsigned x, unsigned& nloc, unsigned& nx) {
    const unsigned G = gridDim.x * gridDim.y * gridDim.z;
    unsigned sum, cnt, mine, sp = 0u;
    for (;;) {
        sum = 0u; cnt = 0u; mine = 0u;
#pragma unroll
        for (unsigned j = 0; j < 16; ++j) { const unsigned c = xb_ld(&bar[XB_XCNT(j)]); sum += c; cnt += (c > 0u) ? 1u : 0u; mine = (j == x) ? c : mine; }
        if (sum == G) break;
        __builtin_amdgcn_s_sleep(1);
        if ((++sp & 255u) == 0u) { if (xb_ld(&bar[XB_TMO])) break; if (sp > XB_SPIN_CAP) { atomicAdd(&bar[XB_TMO], 1u); break; } }
    }
    nloc = mine > 0u ? mine : 1u; nx = cnt > 0u ? cnt : 1u;
}

__device__ __forceinline__ void xcd_barrier(const XcdBarrier& b) {
    asm volatile("s_waitcnt vmcnt(0)" ::: "memory");
    __syncthreads();
    if (threadIdx.x == 0) {
        unsigned* bar = b.bar;
        __builtin_amdgcn_s_waitcnt(0);
        unsigned nloc = b.st[0], nx = b.st[1];
        if (nloc == 0u) { xcd_barrier_complete(bar, b.x, nloc, nx); b.st[0] = nloc; b.st[1] = nx; }
        const unsigned old = xb_add(&bar[XB_XSUB(b.x)], 1u);
        const unsigned gen = old / nloc;
        if (old + 1u == (gen + 1u) * nloc) {
            __builtin_amdgcn_fence(__ATOMIC_RELEASE, "agent");
            asm volatile("s_waitcnt vmcnt(0)" ::: "memory");
            const unsigned og = xb_add(&bar[XB_TOP], 1u);
            const unsigned tg = og / nx;
            if (og + 1u == (tg + 1u) * nx) xb_add(&bar[XB_TOPGEN], 1u);
            else XB_SPIN(xb_ld(&bar[XB_TOPGEN]) == tg, bar);
            __builtin_amdgcn_fence(__ATOMIC_ACQUIRE, "agent");
            xb_add(&bar[XB_XGEN(b.x)], 1u);
            asm volatile("s_waitcnt vmcnt(0)" ::: "memory");
        } else {
            XB_SPIN(xb_ld(&bar[XB_XGEN(b.x)]) == gen, bar);
            __builtin_amdgcn_fence(__ATOMIC_ACQUIRE, "agent");
            asm volatile("s_waitcnt vmcnt(0)" ::: "memory");
        }
    }
    __syncthreads();
}
struct Params {
    const float *x, *a_w_in, *a_conv_w, *a_log, *a_dt, *a_norm_w, *a_w_out, *b_w_kv, *b_w_q, *b_w_o, *ffn_w1, *ffn_w3, *ffn_w2, *moe_router, *moe_w1, *moe_w3, *moe_w2, *ln_g, *ln_b;
    float* out;
    bf16_t *Wt_in, *Wt_out, *Wt_13, *Wt_2, *Wt_kvq, *Wt_o, *Wt_m13, *Wt_m2;
    bf16_t *xb, *proj, *ogb, *x1b, *hidb, *x2b, *Kb, *Vb, *Qb, *attb, *x3b;
    float *g, *beta, *cs, *sn, *ypre, *x1, *x2, *kmp, *x3, *tg, *gate_of_slot, *of;
    bf16_t *hidm, *ysb;
    int *te, *pos_of, *gcnt, *tok_of_slot, *slot_of;
    unsigned* bar;
    int cvt_split, pad0;
    CvtTable cvt;
};

enum { PH_PROLOGUE = 0, PH_PROJ, PH_DN, PH_DNPOST, PH_WOUT, PH_LN1, PH_FFN_UP, PH_FFN_DN, PH_LN2, PH_KVQ, PH_ATTN, PH_WO, PH_LN3, PH_LN3R, PH_CVT_MOE, PH_MAP, PH_MUP_A, PH_MDN_A, PH_MUP_B, PH_MDN_B, PH_FINAL };
template <int PH> __device__ __forceinline__ void run_phase(const Params& p, LAS unsigned char* lds) {
    if constexpr (PH == PH_PROLOGUE) {
        phase_x_prep(lds, p.x, p.a_w_in, p.a_log, p.a_dt, p.xb, p.g, p.beta);
        phase_rope_table(p.cs, p.sn);
        if (blockIdx.x == 0 && threadIdx.x < 8) p.gcnt[threadIdx.x] = 0;
        phase_cvt_weights(lds, p.cvt, 0, p.cvt.ntiles);
    } else if constexpr (PH == PH_PROJ) {
        pg8::DenseSched S; S.init(p.xb, p.Wt_in, NT, 4096, DM);
        pg8::EpiBf16 E{p.proj, 4096, 0};
        pg8::gemm_phase<pg8::EpiBf16, pg8::DenseSched, false>(lds, DM, S, E, nullptr);
    } else if constexpr (PH == PH_DN) {
        phase_dn(lds, p.proj, p.a_conv_w, p.g, p.beta, p.of);
    } else if constexpr (PH == PH_DNPOST) {
        phase_dn_post(p.of, p.proj, p.a_norm_w, p.ogb);
    } else if constexpr (PH == PH_WOUT) {
        pg8::DenseSched S; S.init(p.ogb, p.Wt_out, NT, DM, DM);
        pg8::EpiResF32 E{p.ypre, p.x, DM, 0};
        pg8::gemm_phase<pg8::EpiResF32, pg8::DenseSched, false>(lds, DM, S, E, nullptr);
    } else if constexpr (PH == PH_LN1) {
        phase_ln(p.ypre, p.ln_g + 0 * DM, p.ln_b + 0 * DM, p.x1, p.x1b);
    } else if constexpr (PH == PH_FFN_UP) {
        pg8::DenseSched S; S.init(p.x1b, p.Wt_13, NT, 2 * FF, DM);
        pg8::EpiSwiGLU E{p.hidb, FF, 0};
        pg8::gemm_phase<pg8::EpiSwiGLU, pg8::DenseSched, false>(lds, DM, S, E, nullptr);
    } else if constexpr (PH == PH_FFN_DN) {
        pg8::DenseSched S; S.init(p.hidb, p.Wt_2, NT, DM, FF);
        pg8::EpiResF32 E{p.ypre, p.x1, DM, 0};
        pg8::gemm_phase<pg8::EpiResF32, pg8::DenseSched, false>(lds, FF, S, E, nullptr);
    } else if constexpr (PH == PH_LN2) {
        phase_ln(p.ypre, p.ln_g + 1 * DM, p.ln_b + 1 * DM, p.x2, p.x2b);
    } else if constexpr (PH == PH_KVQ) {
        pg8::DenseSched S; S.init(p.x2b, p.Wt_kvq, NT, 3072, DM);
        pg8::EpiKVQ E{p.Kb, p.Vb, p.Qb, p.kmp, p.cs, p.sn};
        pg8::gemm_phase<pg8::EpiKVQ, pg8::DenseSched, false>(lds, DM, S, E, nullptr);
    } else if constexpr (PH == PH_ATTN) {
        phase_attn(lds, p.Qb, p.Kb, p.Vb, p.kmp, p.attb);
    } else if constexpr (PH == PH_WO) {
        pg8::DenseSched S; S.init(p.attb, p.Wt_o, NT, DM, DM);
        pg8::EpiResF32 E{p.ypre, p.x2, DM, 0};
        pg8::gemm_phase<pg8::EpiResF32, pg8::DenseSched, false>(lds, DM, S, E, nullptr);
    } else if constexpr (PH == PH_LN3) {
        phase_ln(p.ypre, p.ln_g + 2 * DM, p.ln_b + 2 * DM, p.x3, p.x3b);
    } else if constexpr (PH == PH_LN3R) {
        phase_ln_router(lds, p.ypre, p.ln_g + 2 * DM, p.ln_b + 2 * DM, p.moe_router, p.x3, p.x3b, p.te, p.tg, p.pos_of, p.gcnt, p.tok_of_slot);
    } else if constexpr (PH == PH_CVT_MOE) {
        phase_cvt_weights(lds, p.cvt, p.cvt_split, p.cvt.ntiles);
    } else if constexpr (PH == PH_MAP) {
        phase_moe_map(p.gcnt, p.te, p.tg, p.pos_of, p.tok_of_slot, p.gate_of_slot, p.slot_of);
    } else if constexpr (PH == PH_MUP_A || PH == PH_MUP_B || PH == PH_MDN_A || PH == PH_MDN_B) {
        constexpr bool UP = (PH == PH_MUP_A || PH == PH_MUP_B), HB = (PH == PH_MUP_B || PH == PH_MDN_B);
        pg8::MoeSched S; moe_offsets(p.gcnt, S.off);
        const int nrt = S.off[8] >> 8, half = (nrt + 1) >> 1;
        S.rt0 = HB ? half : 0; S.rt1 = HB ? nrt : half; S.G = (int)gridDim.x; S.c = (int)blockIdx.x;
        if constexpr (UP) {
            S.A = (const char*)p.x3b; S.Bt = (const char*)p.Wt_m13; S.nN = 2 * FF / 256; S.gather = 1; S.tstepA = 0; S.tstepB = (size_t)256 * DM * 2; S.estride = (size_t)2 * FF * DM * 2;
            pg8::EpiSwiGLU E{p.hidm, FF, S.rt0 * 256};
            pg8::gemm_phase<pg8::EpiSwiGLU, pg8::MoeSched, true>(lds, DM, S, E, p.tok_of_slot);
        } else {
            S.A = (const char*)p.hidm; S.Bt = (const char*)p.Wt_m2; S.nN = DM / 256; S.gather = 0; S.tstepA = (size_t)256 * FF * 2; S.tstepB = (size_t)256 * FF * 2; S.estride = (size_t)DM * FF * 2;
            pg8::EpiMoeDown E{p.ysb, p.gate_of_slot};
            pg8::gemm_phase<pg8::EpiMoeDown, pg8::MoeSched, false>(lds, FF, S, E, nullptr);
        }
    } else if constexpr (PH == PH_FINAL) {
        phase_final(p.x3, p.ysb, p.slot_of, p.ln_g + 3 * DM, p.ln_b + 3 * DM, p.out);
    }
}
template <int PH> __global__ __launch_bounds__(512, 2) void k_ph(Params p) {
    extern __shared__ __attribute__((aligned(16))) unsigned char shm[];
    run_phase<PH>(p, (LAS unsigned char*)shm);
}
constexpr int LDS_BYTES = 147456 + 256;
__global__ __launch_bounds__(512, 2) void k_mega(Params p) {
    extern __shared__ __attribute__((aligned(16))) unsigned char shm[];
    LAS unsigned char* lds = (LAS unsigned char*)shm;
    volatile LAS unsigned* xbw = (volatile LAS unsigned*)(lds + 147456);
    if (threadIdx.x == 0) { xbw[0] = 0u; xbw[1] = 0u; xbw[2] = 0u; xbw[3] = 0u; }
    __syncthreads();
    XcdBarrier bar = xcd_barrier_post(p.bar, xbw);
    run_phase<PH_PROLOGUE>(p, lds); xcd_barrier(bar);
    run_phase<PH_PROJ>(p, lds);     xcd_barrier(bar);
    run_phase<PH_DN>(p, lds);       xcd_barrier(bar);
    run_phase<PH_DNPOST>(p, lds);   xcd_barrier(bar);
    run_phase<PH_WOUT>(p, lds);     xcd_barrier(bar);
    run_phase<PH_LN1>(p, lds);      xcd_barrier(bar);
    run_phase<PH_FFN_UP>(p, lds);   xcd_barrier(bar);
    run_phase<PH_FFN_DN>(p, lds);   xcd_barrier(bar);
    run_phase<PH_LN2>(p, lds);      xcd_barrier(bar);
    run_phase<PH_KVQ>(p, lds);      xcd_barrier(bar);
    run_phase<PH_ATTN>(p, lds);     xcd_barrier(bar);
    run_phase<PH_WO>(p, lds);       xcd_barrier(bar);
    run_phase<PH_LN3R>(p, lds);     xcd_barrier(bar);
    run_phase<PH_MAP>(p, lds);      xcd_barrier(bar);
    run_phase<PH_MUP_A>(p, lds);    xcd_barrier(bar);
    run_phase<PH_MDN_A>(p, lds);    xcd_barrier(bar);
    run_phase<PH_MUP_B>(p, lds);    xcd_barrier(bar);
    run_phase<PH_MDN_B>(p, lds);    xcd_barrier(bar);
    run_phase<PH_FINAL>(p, lds);
}
template <int PH> static void launch_phase(const Params& p, hipStream_t stream) {
    static bool attr_done = false;
    if (!attr_done) { attr_done = true; (void)hipFuncSetAttribute((const void*)k_ph<PH>, hipFuncAttributeMaxDynamicSharedMemorySize, LDS_BYTES); }
    k_ph<PH><<<256, NTHR, LDS_BYTES, stream>>>(p);
}
static void build_cvt(CvtTable& tb, const Params& p) {
    int n = 0, tile = 0;
    auto add = [&](const float* s0, const float* s1, bf16_t* dst, int K, int N, int ld, int mode) { CvtJob& j = tb.j[n++]; j.src0 = s0; j.src1 = s1; j.dst = dst; j.K = K; j.N = N; j.ld = ld; j.mode = mode; j.tile0 = tile; j.pad = 0; tile += (N / 64) * (K / 128); };
    add(p.a_w_in, nullptr, p.Wt_in, DM, 4096, NPROJ, 0);
    add(p.a_w_out, nullptr, p.Wt_out, DM, DM, DM, 0);
    add(p.ffn_w1, p.ffn_w3, p.Wt_13, DM, 2 * FF, FF, 1);
    add(p.ffn_w2, nullptr, p.Wt_2, FF, DM, DM, 0);
    add(p.b_w_kv, nullptr, p.Wt_kvq, DM, 1024, 2048, 2);
    add(p.b_w_kv + 1024, nullptr, p.Wt_kvq + (size_t)1024 * DM, DM, 1024, 2048, 0);
    add(p.b_w_q, nullptr, p.Wt_kvq + (size_t)2048 * DM, DM, 1024, DM, 2);
    add(p.b_w_o, nullptr, p.Wt_o, DM, DM, DM, 0);
    for (int e = 0; e < NE; ++e) add(p.moe_w1 + (size_t)e * DM * FF, p.moe_w3 + (size_t)e * DM * FF, p.Wt_m13 + (size_t)e * 2 * FF * DM, DM, 2 * FF, FF, 1);
    for (int e = 0; e < NE; ++e) add(p.moe_w2 + (size_t)e * FF * DM, nullptr, p.Wt_m2 + (size_t)e * DM * FF, FF, DM, DM, 0);
    tb.ntiles = tile; tb.pad = 0;
}

extern "C" void kernel_launch(void* const* d_in, const int* in_sizes, int n_in, void* d_out, int out_size, void* d_ws, size_t ws_size, hipStream_t stream) {
    static Params p;
    p.x = (const float*)d_in[0]; p.a_w_in = (const float*)d_in[1]; p.a_conv_w = (const float*)d_in[2]; p.a_log = (const float*)d_in[3]; p.a_dt = (const float*)d_in[4];
    p.a_norm_w = (const float*)d_in[5]; p.a_w_out = (const float*)d_in[6]; p.b_w_kv = (const float*)d_in[7]; p.b_w_q = (const float*)d_in[8]; p.b_w_o = (const float*)d_in[9];
    p.ffn_w1 = (const float*)d_in[10]; p.ffn_w3 = (const float*)d_in[11]; p.ffn_w2 = (const float*)d_in[12]; p.moe_router = (const float*)d_in[13];
    p.moe_w1 = (const float*)d_in[14]; p.moe_w3 = (const float*)d_in[15]; p.moe_w2 = (const float*)d_in[16]; p.ln_g = (const float*)d_in[17]; p.ln_b = (const float*)d_in[18];
    p.out = (float*)d_out;
    char* ws = (char*)d_ws; size_t o = 0;
    auto take = [&](size_t bytes) { char* r = ws + o; o += (bytes + 255) & ~(size_t)255; return r; };
    p.Wt_in = (bf16_t*)take((size_t)4096 * DM * 2); p.Wt_out = (bf16_t*)take((size_t)DM * DM * 2); p.Wt_13 = (bf16_t*)take((size_t)2 * FF * DM * 2); p.Wt_2 = (bf16_t*)take((size_t)DM * FF * 2);
    p.Wt_kvq = (bf16_t*)take((size_t)3072 * DM * 2); p.Wt_o = (bf16_t*)take((size_t)DM * DM * 2);
    p.Wt_m13 = (bf16_t*)take((size_t)NE * 2 * FF * DM * 2); p.Wt_m2 = (bf16_t*)take((size_t)NE * DM * FF * 2);
    p.g = (float*)take((size_t)NT * 8 * 4); p.beta = (float*)take((size_t)NT * 8 * 4); p.cs = (float*)take((size_t)SEQ * 64 * 4); p.sn = (float*)take((size_t)SEQ * 64 * 4);
    p.kmp = (float*)take((size_t)64 * 8 * 2 * 128 * 4); p.te = (int*)take((size_t)NT * 2 * 4); p.tg = (float*)take((size_t)NT * 2 * 4); p.pos_of = (int*)take((size_t)NT * 2 * 4); p.slot_of = (int*)take((size_t)NT * 2 * 4);
    p.tok_of_slot = (int*)take((size_t)MAXSLOT * 4); p.gate_of_slot = (float*)take((size_t)MAXSLOT * 4); p.gcnt = (int*)take(256); p.bar = (unsigned*)take(XCD_BAR_WORDS * sizeof(unsigned));
    const size_t U = (size_t)NT * DM * 4;
    char* act = take(3 * U + U / 2);
    if (o > ws_size) { fprintf(stderr, "workspace too small: need %zu have %zu\n", o, ws_size); return; }
    p.xb = (bf16_t*)act; p.proj = (bf16_t*)(act + U / 2); p.of = p.out; p.ogb = (bf16_t*)(act + 2 * U + U / 2);
    p.ypre = p.out; p.x1 = (float*)act; p.x1b = (bf16_t*)(act + U); p.hidb = (bf16_t*)(act + U + U / 2);
    p.x2 = (float*)act; p.x2b = (bf16_t*)(act + U);
    p.Kb = (bf16_t*)(act + U + U / 2); p.Vb = (bf16_t*)(act + 2 * U); p.Qb = (bf16_t*)(act + 2 * U + U / 2); p.attb = (bf16_t*)(act + 3 * U);
    p.x3 = p.out; p.x3b = (bf16_t*)act; p.ysb = (bf16_t*)(act + U / 2); p.hidm = (bf16_t*)(act + U / 2 + (size_t)MAXSLOT * DM * 2);
    build_cvt(p.cvt, p); p.cvt_split = p.cvt.j[8].tile0; p.pad0 = 0;
    static int grid = 0;
    if (!grid) {
        int dev = 0, cus = 0, per_cu = 0;
        (void)hipGetDevice(&dev); (void)hipDeviceGetAttribute(&cus, hipDeviceAttributeMultiprocessorCount, dev);
        (void)hipFuncSetAttribute((const void*)k_mega, hipFuncAttributeMaxDynamicSharedMemorySize, LDS_BYTES);
        (void)hipOccupancyMaxActiveBlocksPerMultiprocessor(&per_cu, (const void*)k_mega, NTHR, LDS_BYTES);
        grid = (cus >= 256 && per_cu >= 1) ? 256 : -1;
        if (grid < 0) fprintf(stderr, "kernel_launch: need 256 CUs with one resident 512-thread workgroup each (cus %d, per_cu %d)\n", cus, per_cu);
    }
    if (grid < 0) return;
    (void)hipMemsetAsync(p.bar, 0, XCD_BAR_WORDS * sizeof(unsigned), stream);
    k_mega<<<grid, NTHR, LDS_BYTES, stream>>>(p);
}
```

```cpp
#include <hip/hip_runtime.h>
#include <cstdint>
#include <cstdio>
#define LAS __attribute__((address_space(3)))
typedef unsigned short bf16_t;
typedef short bf16x8 __attribute__((ext_vector_type(8)));
typedef float f32x4 __attribute__((ext_vector_type(4)));
typedef float f32x2 __attribute__((ext_vector_type(2)));
typedef unsigned u32x4 __attribute__((ext_vector_type(4)));
typedef unsigned u32x2 __attribute__((ext_vector_type(2)));

constexpr int NB = 8, SEQ = 2048, DM = 1024, NT = NB * SEQ, NH = 8, DH = 128;
constexpr int NPROJ = 4112, FF = 3584, NE = 8, MAXSLOT = 34816;
constexpr float ALPHA = 1.41421356237309515f;
constexpr float LN_EPS = 1e-5f;
constexpr int NTHR = 512;

__device__ __forceinline__ int otid() { int t = threadIdx.x; asm volatile("" : "+v"(t)); return t; }
__device__ __forceinline__ float ld_agent_f32(const float* p) { return __uint_as_float(__hip_atomic_load((const unsigned*)p, __ATOMIC_RELAXED, __HIP_MEMORY_SCOPE_AGENT)); }
__device__ __forceinline__ int ld_agent_i32(const int* p) { return __hip_atomic_load(p, __ATOMIC_RELAXED, __HIP_MEMORY_SCOPE_AGENT); }
__device__ __forceinline__ unsigned cvt_pk_bf16(float lo, float hi) { unsigned r; asm volatile("v_cvt_pk_bf16_f32 %0, %1, %2" : "=v"(r) : "v"(lo), "v"(hi)); return r; }
typedef __bf16 bf16x2_t __attribute__((ext_vector_type(2)));
__device__ __forceinline__ unsigned cvt_pk_bf16_c(float lo, float hi) { f32x2 f = {lo, hi}; bf16x2_t v = __builtin_convertvector(f, bf16x2_t); return *reinterpret_cast<unsigned*>(&v); }
__device__ __forceinline__ float bf2f(unsigned short b) { return __uint_as_float(((unsigned)b) << 16); }
__device__ __forceinline__ float bflo(unsigned w) { return __uint_as_float(w << 16); }
__device__ __forceinline__ float bfhi(unsigned w) { return __uint_as_float(w & 0xffff0000u); }
__device__ __forceinline__ float silu_f(float x) { return x / (1.f + __expf(-x)); }

namespace pg8 {
constexpr int BM = 256, BK = 64, HALF = 128, HTB = HALF * BK * 2, STAGE_BYTES = 8 * HTB, NXCD = 8, WGM = 8;
__host__ __device__ __forceinline__ int lds_byte(int r, int c) { const int st = (r >> 4) * 2 + (c >> 5), rr = r & 15, cc = c & 31, ob = rr * 64 + cc * 2; return st * 1024 + (ob ^ (((ob >> 9) & 1) << 5)); }
__host__ __device__ __forceinline__ void stage_rc(int b, int& R, int& C) { const int st = b / 1024, sb = b % 1024, swz = sb ^ (((sb >> 9) & 1) << 5); R = (st >> 1) * 16 + swz / 64; C = (st & 1) * 32 + (swz % 64) / 2; }
__host__ __device__ __forceinline__ int perm32(int rho) { const int n = rho >> 4, i = rho & 15; return 8 * (i >> 2) + 4 * n + (i & 3); }

struct Unit { int pm, pn, arow, nt, kind, kc; const char* A; const char* B; };

__device__ __forceinline__ bool tile_order(long L, int nM, int nN, int& pm, int& pn) {
    const int nwg = nM * nN; if (L >= nwg) return false;
    int wgid = (int)L; { const int q = nwg / NXCD, r = nwg % NXCD, xcd = wgid % NXCD, off = wgid / NXCD; wgid = (xcd < r ? xcd * (q + 1) : r * (q + 1) + (xcd - r) * q) + off; }
    const int nig = WGM * nN, gid = wgid / nig, fm = gid * WGM, gsz = (nM - fm) < WGM ? (nM - fm) : WGM;
    pm = fm + ((wgid % nig) % gsz); pn = (wgid % nig) / gsz; return true;
}
struct DenseSched {
    const char* A; const char* Bt; int nM, nN, G, c, ntk; size_t tstep;
    __device__ __forceinline__ void init(const void* A_, const void* Bt_, int M, int N, int K) { A = (const char*)A_; Bt = (const char*)Bt_; nM = M / BM; nN = N / BM; G = (int)gridDim.x; c = (int)blockIdx.x; ntk = K / BK; tstep = (size_t)BM * K * 2; }
    __device__ __forceinline__ bool next(int i, Unit& u) const {
        int pm, pn; if (!tile_order((long)i * G + c, nM, nN, pm, pn)) return false;
        u.pm = pm; u.pn = pn; u.arow = 0; u.nt = ntk; u.kind = 0; u.kc = 0; u.A = A + (size_t)pm * tstep; u.B = Bt + (size_t)pn * tstep; return true;
    }
};

template <class Epi, class Sched, bool GATHER>
__device__ __forceinline__ void gemm_phase(LAS unsigned char* lds, const int K, const Sched& S, const Epi& E, const int* __restrict__ gidx) {
    const int tid = otid(), wid = __builtin_amdgcn_readfirstlane(tid >> 6), lane = tid & 63, wr = wid >> 2, wc = wid & 3, fr = lane & 15, fq = lane >> 4;
    unsigned voffB[2]; unsigned aoffc[2][2], aoffn[2][2]; int rA[2], cA2[2];
    const size_t kstep = (size_t)(BK * 2);
    const unsigned hstep = (unsigned)HALF * (unsigned)K * 2u;
#pragma unroll
    for (int i = 0; i < 2; ++i) { int R, C; stage_rc(tid * 16 + i * 8192, R, C); const int Rb = Epi::PERM ? ((R & ~31) + perm32(R & 31)) : R;
        rA[i] = R; cA2[i] = C * 2; voffB[i] = (unsigned)(Rb * K + C) * 2u;
        aoffc[0][i] = (unsigned)(R * K + C) * 2u; aoffc[1][i] = aoffc[0][i] + hstep; aoffn[0][i] = aoffc[0][i]; aoffn[1][i] = aoffc[1][i]; }
    const unsigned ldsw = (unsigned)wid * 1024u;
    const int aoff = lds_byte(wr * 64 + fr, fq * 8), boff = lds_byte(wc * 32 + fr, fq * 8);
#define PG8_SA(b, h) (((b) * 2 + (h)) * HTB)
#define PG8_SB(b, h) ((4 + (b) * 2 + (h)) * HTB)
#define PG8_STAGE_A(bufoff, gbase, offs) do { _Pragma("unroll") for (int _i = 0; _i < 2; ++_i) \
        __builtin_amdgcn_global_load_lds((const unsigned*)((const char*)(gbase) + (offs)[_i]), (LAS unsigned*)(lds + (bufoff) + ldsw + _i * 8192), 16, 0, 0); } while (0)
#define PG8_STAGE_B(bufoff, gbase) do { _Pragma("unroll") for (int _i = 0; _i < 2; ++_i) \
        __builtin_amdgcn_global_load_lds((const unsigned*)((const char*)(gbase) + voffB[_i]), (LAS unsigned*)(lds + (bufoff) + ldsw + _i * 8192), 16, 0, 0); } while (0)
#define PG8_LDA(dst, b, h) do { _Pragma("unroll") for (int m = 0; m < 4; ++m) _Pragma("unroll") for (int k = 0; k < 2; ++k) dst[m][k] = *(const LAS bf16x8*)(lds + PG8_SA(b, h) + aoff + m * 2048 + k * 1024); } while (0)
#define PG8_LDB(dst, b, h) do { _Pragma("unroll") for (int n = 0; n < 2; ++n) _Pragma("unroll") for (int k = 0; k < 2; ++k) dst[n][k] = *(const LAS bf16x8*)(lds + PG8_SB(b, h) + boff + n * 2048 + k * 1024); } while (0)
#define PG8_MMA(ai, bj, At, Bt) do { __builtin_amdgcn_s_setprio(1); _Pragma("unroll") for (int m = 0; m < 4; ++m) _Pragma("unroll") for (int n = 0; n < 2; ++n) _Pragma("unroll") for (int k = 0; k < 2; ++k) \
        acc[ai][bj][m][n] = __builtin_amdgcn_mfma_f32_16x16x32_bf16(Bt[n][k], At[m][k], acc[ai][bj][m][n], 0, 0, 0); __builtin_amdgcn_s_setprio(0); } while (0)
#define PG8_WAIT_V(n) asm volatile("s_waitcnt vmcnt(" #n ")" ::: "memory")
#define PG8_WAIT_L(n) asm volatile("s_waitcnt lgkmcnt(" #n ")" ::: "memory")
#define PG8_BAR __builtin_amdgcn_s_barrier()
#define PG8_SCHED __builtin_amdgcn_sched_barrier(0)
#define PG8_GOFFS(dst, ui_) do { if (GATHER) { _Pragma("unroll") for (int _h = 0; _h < 2; ++_h) _Pragma("unroll") for (int _i = 0; _i < 2; ++_i) \
        dst[_h][_i] = gtab[(ui_) * 256 + _h * HALF + rA[_i]] + (unsigned)cA2[_i]; } } while (0)
    Unit cur, nxt; int ui = 0;
    if (!S.next(0, cur)) return;
    LAS unsigned* gtab = (LAS unsigned*)(lds + STAGE_BYTES);
    if (GATHER) { Unit uu;
        for (int i = 0; i < 16 && S.next(i, uu); ++i) { if (tid < 256) { int t_ = gidx[uu.arow + tid]; t_ = t_ < 0 ? 0 : t_; gtab[i * 256 + tid] = (unsigned)t_ * (unsigned)(K * 2); } }
        __syncthreads(); }
    f32x4 acc[2][2][4][2];
#pragma unroll
    for (int a = 0; a < 2; ++a)
#pragma unroll
        for (int b = 0; b < 2; ++b)
#pragma unroll
            for (int m = 0; m < 4; ++m)
#pragma unroll
                for (int n = 0; n < 2; ++n) acc[a][b][m][n] = (f32x4){0.f, 0.f, 0.f, 0.f};
    bf16x8 At[4][2], B0[2][2], B1[2][2];
    const char* cA = cur.A; const char* cB = cur.B;
    PG8_GOFFS(aoffc, 0);
    PG8_STAGE_B(PG8_SB(0, 0), cB); PG8_STAGE_A(PG8_SA(0, 0), cA, aoffc[0]); PG8_STAGE_B(PG8_SB(0, 1), cB + hstep); PG8_STAGE_A(PG8_SA(0, 1), cA, aoffc[1]);
    if (wr == 1) PG8_BAR;
    PG8_WAIT_V(4); PG8_BAR;
    PG8_STAGE_B(PG8_SB(1, 0), cB + kstep); PG8_STAGE_A(PG8_SA(1, 0), cA + kstep, aoffc[0]); PG8_STAGE_B(PG8_SB(1, 1), cB + hstep + kstep);
    PG8_WAIT_V(6); PG8_BAR;
    for (;;) {
        const bool has_next = S.next(ui + 1, nxt);
        const char* nA = has_next ? nxt.A : cA; const char* nB = has_next ? nxt.B : cB;
        if (GATHER) { if (has_next) { PG8_GOFFS(aoffn, ui + 1); } else {
#pragma unroll
            for (int h = 0; h < 2; ++h)
#pragma unroll
                for (int i = 0; i < 2; ++i) aoffn[h][i] = aoffc[h][i]; } }
        const int nt = cur.nt;
        for (int t = 0; t < nt; t += 2) {
            const bool last = (t == nt - 2);
            const char* a1 = cA + (size_t)(t + 1) * kstep;
            const char* a2 = last ? nA : cA + (size_t)(t + 2) * kstep; const char* b2 = last ? nB : cB + (size_t)(t + 2) * kstep;
            const char* a3 = a2 + kstep; const char* b3 = b2 + kstep;
            unsigned a2o[2][2];
#pragma unroll
            for (int h = 0; h < 2; ++h)
#pragma unroll
                for (int i = 0; i < 2; ++i) a2o[h][i] = (GATHER && last) ? aoffn[h][i] : aoffc[h][i];
            PG8_LDB(B0, 0, 0); PG8_SCHED; PG8_LDA(At, 0, 0); PG8_STAGE_A(PG8_SA(1, 1), a1, aoffc[1]);
            PG8_WAIT_L(8); PG8_BAR; PG8_WAIT_L(0); PG8_MMA(0, 0, At, B0); PG8_BAR; PG8_SCHED;
            PG8_LDB(B1, 0, 1); PG8_STAGE_B(PG8_SB(0, 0), b2);
            PG8_BAR; PG8_WAIT_L(0); PG8_MMA(0, 1, At, B1); PG8_BAR;
            PG8_LDA(At, 0, 1); PG8_STAGE_A(PG8_SA(0, 0), a2, a2o[0]);
            PG8_BAR; PG8_WAIT_L(0); PG8_MMA(1, 0, At, B0); PG8_BAR; PG8_SCHED;
            PG8_STAGE_B(PG8_SB(0, 1), b2 + hstep);
            PG8_WAIT_V(6); PG8_BAR; PG8_MMA(1, 1, At, B1); PG8_BAR;
            PG8_LDB(B0, 1, 0); PG8_SCHED; PG8_LDA(At, 1, 0); PG8_STAGE_A(PG8_SA(0, 1), a2, a2o[1]);
            PG8_WAIT_L(8); PG8_BAR; PG8_WAIT_L(0); PG8_MMA(0, 0, At, B0); PG8_BAR; PG8_SCHED;
            PG8_LDB(B1, 1, 1); PG8_STAGE_B(PG8_SB(1, 0), b3);
            PG8_BAR; PG8_WAIT_L(0); PG8_MMA(0, 1, At, B1); PG8_BAR;
            PG8_LDA(At, 1, 1); PG8_STAGE_A(PG8_SA(1, 0), a3, a2o[0]);
            PG8_BAR; PG8_WAIT_L(0); PG8_MMA(1, 0, At, B0); PG8_BAR; PG8_SCHED;
            PG8_STAGE_B(PG8_SB(1, 1), b3 + hstep);
            PG8_WAIT_V(6); PG8_BAR; PG8_MMA(1, 1, At, B1); PG8_BAR;
        }
        E(acc, cur, wr, wc, fr, fq);
        if (!has_next) break;
#pragma unroll
        for (int a = 0; a < 2; ++a)
#pragma unroll
            for (int b = 0; b < 2; ++b)
#pragma unroll
                for (int m = 0; m < 4; ++m)
#pragma unroll
                    for (int n = 0; n < 2; ++n) acc[a][b][m][n] = (f32x4){0.f, 0.f, 0.f, 0.f};
        cur = nxt; cA = nA; cB = nB; ++ui;
        if (GATHER) {
#pragma unroll
            for (int h = 0; h < 2; ++h)
#pragma unroll
                for (int i = 0; i < 2; ++i) aoffc[h][i] = aoffn[h][i]; }
    }
    PG8_WAIT_V(0);
    if (wr == 0) PG8_BAR;
    PG8_BAR;
#undef PG8_SA
#undef PG8_SB
#undef PG8_STAGE_A
#undef PG8_STAGE_B
#undef PG8_LDA
#undef PG8_LDB
#undef PG8_MMA
#undef PG8_WAIT_V
#undef PG8_WAIT_L
#undef PG8_BAR
#undef PG8_SCHED
#undef PG8_GOFFS
}

struct EpiBf16 {
    static constexpr bool PERM = true;
    bf16_t* O; int ldc; int pad;
    __device__ __forceinline__ void operator()(const f32x4 (&acc)[2][2][4][2], const Unit& u, int wr, int wc, int fr, int fq) const {
        const int row0 = u.pm * BM + wr * 64 + fr, col0 = u.pn * BM + wc * 32 + 8 * fq;
#pragma unroll
        for (int ai = 0; ai < 2; ++ai)
#pragma unroll
            for (int m = 0; m < 4; ++m) { bf16_t* rowp = O + (size_t)(row0 + ai * HALF + m * 16) * ldc + col0;
#pragma unroll
                for (int bj = 0; bj < 2; ++bj) { const f32x4 v0 = acc[ai][bj][m][0], v1 = acc[ai][bj][m][1];
                    u32x4 w; w.x = cvt_pk_bf16(v0[0], v0[1]); w.y = cvt_pk_bf16(v0[2], v0[3]); w.z = cvt_pk_bf16(v1[0], v1[1]); w.w = cvt_pk_bf16(v1[2], v1[3]);
                    *(u32x4*)(rowp + bj * HALF) = w; } }
    }
};
struct EpiResF32 {
    static constexpr bool PERM = false;
    float* C; const float* X; int ldc; int pad;
    __device__ __forceinline__ void operator()(const f32x4 (&acc)[2][2][4][2], const Unit& u, int wr, int wc, int fr, int fq) const {
        const int row0 = u.pm * BM + wr * 64 + fr, col0 = u.pn * BM + wc * 32 + 4 * fq;
        f32x4 xv[2][4];
#pragma unroll
        for (int q = 0; q < 4; ++q) xv[0][q] = *(const f32x4*)(X + (size_t)row0 * ldc + col0 + (q >> 1) * HALF + (q & 1) * 16);
#pragma unroll
        for (int gI = 0; gI < 8; ++gI) { const int ai = gI >> 2, m = gI & 3; const size_t off = (size_t)(row0 + ai * HALF + m * 16) * ldc + col0;
            if (gI + 1 < 8) { const int ai2 = (gI + 1) >> 2, m2 = (gI + 1) & 3; const size_t off2 = (size_t)(row0 + ai2 * HALF + m2 * 16) * ldc + col0;
#pragma unroll
                for (int q = 0; q < 4; ++q) xv[(gI + 1) & 1][q] = *(const f32x4*)(X + off2 + (q >> 1) * HALF + (q & 1) * 16); }
#pragma unroll
            for (int q = 0; q < 4; ++q) *(f32x4*)(C + off + (q >> 1) * HALF + (q & 1) * 16) = xv[gI & 1][q] * ALPHA + acc[ai][q >> 1][m][q & 1]; }
    }
};
}

struct CvtJob { const float* src0; const float* src1; bf16_t* dst; int K, N, ld, mode, tile0, pad; };
constexpr int NJOBS = 24;
struct CvtTable { CvtJob j[NJOBS]; int ntiles; int pad; };

__device__ __forceinline__ void cvt_tile_src(const CvtJob& jb, int tl, const float*& src, bf16_t*& dst) {
    const int nk = jb.K >> 7; const int tn = tl / nk, tk = tl - tn * nk; const int n0 = tn * 64, k0 = tk * 128;
    const float* s = jb.src0; int col0 = n0;
    if (jb.mode == 1) { const int pn = n0 >> 8, bj = (n0 >> 7) & 1, j0 = n0 & 127; s = bj ? jb.src1 : jb.src0; col0 = 128 * pn + j0; }
    else if (jb.mode == 2) { const int pn = n0 >> 8, bj = (n0 >> 7) & 1, j0 = n0 & 127; col0 = (2 * pn + (j0 >> 6)) * 128 + 64 * bj; }
    src = s + (size_t)k0 * jb.ld + col0; dst = jb.dst + (size_t)n0 * jb.K + k0;
}
__device__ __forceinline__ void phase_cvt_weights(LAS unsigned char* lds, const CvtTable& tb, const int t_begin, const int t_end) {
    LAS float* tile = (LAS float*)lds;
    const int tid = otid();
    int tl = t_begin + blockIdx.x; if (tl >= t_end) return;
    auto find = [&](int t) { int ji = 0;
#pragma unroll 1
        for (int q = 1; q < NJOBS; ++q) if (t >= tb.j[q].tile0) ji = q; return ji; };
    f32x4 v[4]; const float* src; bf16_t* dst; int ji = find(tl); int ld = tb.j[ji].ld, Kd = tb.j[ji].K;
    cvt_tile_src(tb.j[ji], tl - tb.j[ji].tile0, src, dst);
#pragma unroll
    for (int i = 0; i < 4; ++i) { const int idx = tid + 512 * i; v[i] = *(const f32x4*)(src + (size_t)(idx >> 4) * ld + (idx & 15) * 4); }
    for (;;) {
        __syncthreads();
#pragma unroll
        for (int i = 0; i < 4; ++i) { const int idx = tid + 512 * i; const int r = idx >> 4, c = (idx & 15) * 4; LAS float* p = tile + r * 65 + c; p[0] = v[i][0]; p[1] = v[i][1]; p[2] = v[i][2]; p[3] = v[i][3]; }
        bf16_t* dcur = dst; const int Kcur = Kd;
        const int tn = tl + gridDim.x; const bool more = tn < t_end;
        if (more) { ji = find(tn); ld = tb.j[ji].ld; Kd = tb.j[ji].K; cvt_tile_src(tb.j[ji], tn - tb.j[ji].tile0, src, dst);
#pragma unroll
            for (int i = 0; i < 4; ++i) { const int idx = tid + 512 * i; v[i] = *(const f32x4*)(src + (size_t)(idx >> 4) * ld + (idx & 15) * 4); } }
        __syncthreads();
        const int kc = tid & 15, nn = tid >> 4;
#pragma unroll
        for (int p = 0; p < 2; ++p) { const int n = nn + 32 * p; float e[8];
#pragma unroll
            for (int i = 0; i < 8; ++i) e[i] = tile[(8 * kc + i) * 65 + n];
            u32x4 w; w.x = cvt_pk_bf16(e[0], e[1]); w.y = cvt_pk_bf16(e[2], e[3]); w.z = cvt_pk_bf16(e[4], e[5]); w.w = cvt_pk_bf16(e[6], e[7]);
            *(u32x4*)(dcur + (size_t)n * Kcur + 8 * kc) = w; }
        if (!more) break; tl = tn;
    }
    __syncthreads();
}

__device__ __forceinline__ void phase_x_prep(LAS unsigned char* lds, const float* __restrict__ x, const float* __restrict__ w_in, const float* __restrict__ a_log, const float* __restrict__ dt_bias,
                                             bf16_t* __restrict__ xb, float* __restrict__ g, float* __restrict__ beta) {
    LAS float* wab = (LAS float*)lds;
    const int tid = otid(), wid = tid >> 6, lane = tid & 63;
    for (int i = tid; i < 16 * 1024; i += NTHR) { const int c = i >> 4, j = i & 15; wab[j * 1028 + c] = w_in[(size_t)c * NPROJ + 4096 + j]; }
    __syncthreads();
    for (int row = blockIdx.x * 8 + wid; row < NT; row += gridDim.x * 8) {
        float acc[16];
#pragma unroll
        for (int j = 0; j < 16; ++j) acc[j] = 0.f;
#pragma unroll
        for (int i = 0; i < 4; ++i) { const int c = 4 * lane + 256 * i; const f32x4 xv = *(const f32x4*)(x + (size_t)row * DM + c);
            u32x2 w; w.x = cvt_pk_bf16(xv[0], xv[1]); w.y = cvt_pk_bf16(xv[2], xv[3]); *(u32x2*)(xb + (size_t)row * DM + c) = w;
#pragma unroll
            for (int j = 0; j < 16; ++j) { const f32x4 wv = *(const LAS f32x4*)(wab + j * 1028 + c); acc[j] += xv[0] * wv[0] + xv[1] * wv[1] + xv[2] * wv[2] + xv[3] * wv[3]; } }
#pragma unroll
        for (int j = 0; j < 16; ++j) { float s = acc[j]; for (int o = 32; o >= 1; o >>= 1) s += __shfl_xor(s, o); acc[j] = s; }
        float a = 0.f, b = 0.f;
#pragma unroll
        for (int j = 0; j < 8; ++j) { a = (lane == j) ? acc[j] : a; b = (lane == j) ? acc[8 + j] : b; }
        if (lane < 8) { const float xx = a + dt_bias[lane]; const float sp = xx > 20.f ? xx : log1pf(expf(xx));
            g[row * 8 + lane] = -expf(a_log[lane]) * sp; beta[row * 8 + lane] = 1.f / (1.f + expf(-b)); }
    }
    __syncthreads();
}
__device__ __forceinline__ void phase_rope_table(float* __restrict__ cs, float* __restrict__ sn) {
    for (int i = blockIdx.x * NTHR + otid(); i < SEQ * 64; i += gridDim.x * NTHR) { const int pos = i >> 6, f = i & 63;
        const double inv = pow(10000.0, -(double)f / 64.0); const double ang = (double)pos * inv; cs[i] = (float)cos(ang); sn[i] = (float)sin(ang); }
}

namespace pg8 {
struct EpiSwiGLU {
    static constexpr bool PERM = true;
    bf16_t* Hh; int ldc; int row_off;
    __device__ __forceinline__ void operator()(const f32x4 (&acc)[2][2][4][2], const Unit& u, int wr, int wc, int fr, int fq) const {
        const int row0 = u.pm * BM + wr * 64 + fr - row_off, col0 = u.pn * HALF + wc * 32 + 8 * fq;
#pragma unroll
        for (int ai = 0; ai < 2; ++ai)
#pragma unroll
            for (int m = 0; m < 4; ++m) { bf16_t* rowp = Hh + (size_t)(row0 + ai * HALF + m * 16) * ldc + col0;
                float h[8];
#pragma unroll
                for (int n = 0; n < 2; ++n)
#pragma unroll
                    for (int i = 0; i < 4; ++i) { const float g = acc[ai][0][m][n][i], up = acc[ai][1][m][n][i]; h[n * 4 + i] = g * __builtin_amdgcn_rcpf(1.f + __expf(-g)) * up; }
                u32x4 w; w.x = cvt_pk_bf16(h[0], h[1]); w.y = cvt_pk_bf16(h[2], h[3]); w.z = cvt_pk_bf16(h[4], h[5]); w.w = cvt_pk_bf16(h[6], h[7]);
                *(u32x4*)rowp = w; }
    }
};
}

__device__ __forceinline__ void phase_ln(const float* Y, const float* __restrict__ gam, const float* __restrict__ bet, float* xo, bf16_t* __restrict__ xob) {
    const int wid = otid() >> 6, lane = otid() & 63;
    f32x4 gv[4], bv[4];
#pragma unroll
    for (int i = 0; i < 4; ++i) { gv[i] = *(const f32x4*)(gam + 4 * lane + 256 * i); bv[i] = *(const f32x4*)(bet + 4 * lane + 256 * i); }
    for (int row = blockIdx.x * 8 + wid; row < NT; row += gridDim.x * 8) {
        f32x4 v[4]; float s = 0.f;
#pragma unroll
        for (int i = 0; i < 4; ++i) { v[i] = *(const f32x4*)(Y + (size_t)row * DM + 4 * lane + 256 * i); s += (v[i][0] + v[i][1]) + (v[i][2] + v[i][3]); }
        for (int o = 32; o >= 1; o >>= 1) s += __shfl_xor(s, o);
        const float mu = s * (1.f / DM); float q = 0.f;
#pragma unroll
        for (int i = 0; i < 4; ++i) { const f32x4 d = v[i] - mu; q += (d[0] * d[0] + d[1] * d[1]) + (d[2] * d[2] + d[3] * d[3]); }
        for (int o = 32; o >= 1; o >>= 1) q += __shfl_xor(q, o);
        const float rs = rsqrtf(q * (1.f / DM) + LN_EPS);
#pragma unroll
        for (int i = 0; i < 4; ++i) { const f32x4 r = (v[i] - mu) * rs * gv[i] + bv[i]; *(f32x4*)(xo + (size_t)row * DM + 4 * lane + 256 * i) = r;
            u32x2 w; w.x = cvt_pk_bf16(r[0], r[1]); w.y = cvt_pk_bf16(r[2], r[3]); *(u32x2*)(xob + (size_t)row * DM + 4 * lane + 256 * i) = w; }
    }
}

namespace pg8 {
struct EpiKVQ {
    static constexpr bool PERM = true;
    bf16_t *Kb, *Vb, *Qb; float* kmp; const float *cs, *sn;
    __device__ __forceinline__ void operator()(const f32x4 (&acc)[2][2][4][2], const Unit& u, int wr, int wc, int fr, int fq) const {
        const int b = u.pm >> 3, blk = u.pm & 7; const int s0 = blk * 256 + wr * 64 + fr;
        if (u.pn >= 4 && u.pn < 8) {
            const int pnp = u.pn - 4;
#pragma unroll
            for (int bj = 0; bj < 2; ++bj) { const int head = 2 * pnp + bj; bf16_t* base = Vb + ((size_t)(b * NH + head) * SEQ) * DH + wc * 32 + 8 * fq;
#pragma unroll
                for (int ai = 0; ai < 2; ++ai)
#pragma unroll
                    for (int m = 0; m < 4; ++m) { int s = s0 + ai * HALF + m * 16; asm volatile("" : "+v"(s)); const f32x4 v0 = acc[ai][bj][m][0], v1 = acc[ai][bj][m][1];
                        u32x4 w; w.x = cvt_pk_bf16(v0[0], v0[1]); w.y = cvt_pk_bf16(v0[2], v0[3]); w.z = cvt_pk_bf16(v1[0], v1[1]); w.w = cvt_pk_bf16(v1[2], v1[3]);
                        *(u32x4*)(base + (size_t)s * DH) = w; } }
            return;
        }
        const bool isK = u.pn < 4; const int pnp = isK ? u.pn : u.pn - 8;
        const int head = 2 * pnp + (wc >> 1), f0 = 32 * (wc & 1) + 8 * fq;
        bf16_t* base = (isK ? Kb : Qb) + ((size_t)(b * NH + head) * SEQ) * DH + f0;
        float cs1[8], cs2[8];
#pragma unroll
        for (int j = 0; j < 8; ++j) { cs1[j] = 0.f; cs2[j] = 0.f; }
#pragma unroll
        for (int ai = 0; ai < 2; ++ai)
#pragma unroll
            for (int m = 0; m < 4; ++m) { int s = s0 + ai * HALF + m * 16; asm volatile("" : "+v"(s));
                const f32x4 c0 = *(const f32x4*)(cs + s * 64 + f0), c1 = *(const f32x4*)(cs + s * 64 + f0 + 4), n0 = *(const f32x4*)(sn + s * 64 + f0), n1 = *(const f32x4*)(sn + s * 64 + f0 + 4);
                const f32x4 a0 = acc[ai][0][m][0], a1 = acc[ai][0][m][1], b0 = acc[ai][1][m][0], b1 = acc[ai][1][m][1];
                const f32x4 o10 = a0 * c0 - b0 * n0, o11 = a1 * c1 - b1 * n1, o20 = b0 * c0 + a0 * n0, o21 = b1 * c1 + a1 * n1;
                u32x4 w1, w2; w1.x = cvt_pk_bf16(o10[0], o10[1]); w1.y = cvt_pk_bf16(o10[2], o10[3]); w1.z = cvt_pk_bf16(o11[0], o11[1]); w1.w = cvt_pk_bf16(o11[2], o11[3]);
                w2.x = cvt_pk_bf16(o20[0], o20[1]); w2.y = cvt_pk_bf16(o20[2], o20[3]); w2.z = cvt_pk_bf16(o21[0], o21[1]); w2.w = cvt_pk_bf16(o21[2], o21[3]);
                *(u32x4*)(base + (size_t)s * DH) = w1; *(u32x4*)(base + (size_t)s * DH + 64) = w2;
#pragma unroll
                for (int j = 0; j < 4; ++j) { cs1[j] += o10[j]; cs1[4 + j] += o11[j]; cs2[j] += o20[j]; cs2[4 + j] += o21[j]; }
                asm volatile("" : "+v"(cs1[0]), "+v"(cs1[1]), "+v"(cs1[2]), "+v"(cs1[3]), "+v"(cs1[4]), "+v"(cs1[5]), "+v"(cs1[6]), "+v"(cs1[7]),
                                  "+v"(cs2[0]), "+v"(cs2[1]), "+v"(cs2[2]), "+v"(cs2[3]), "+v"(cs2[4]), "+v"(cs2[5]), "+v"(cs2[6]), "+v"(cs2[7]) :: "memory"); }
        if (isK) {
#pragma unroll
            for (int j = 0; j < 8; ++j) {
#pragma unroll
                for (int o = 1; o <= 8; o <<= 1) { cs1[j] += __shfl_xor(cs1[j], o); cs2[j] += __shfl_xor(cs2[j], o); } }
            if (fr == 0) { float* kp = kmp + ((size_t)((b * NH + head) * 8 + blk) * 2 + wr) * 128 + f0;
                *(f32x4*)kp = (f32x4){cs1[0], cs1[1], cs1[2], cs1[3]}; *(f32x4*)(kp + 4) = (f32x4){cs1[4], cs1[5], cs1[6], cs1[7]};
                *(f32x4*)(kp + 64) = (f32x4){cs2[0], cs2[1], cs2[2], cs2[3]}; *(f32x4*)(kp + 68) = (f32x4){cs2[4], cs2[5], cs2[6], cs2[7]}; }
        }
    }
};
}

__device__ __forceinline__ void phase_ln_router(LAS unsigned char* lds, const float* Y, const float* __restrict__ gam, const float* __restrict__ bet, const float* __restrict__ wrt,
                                                float* xo, bf16_t* __restrict__ xob, int* __restrict__ te, float* __restrict__ tg, int* __restrict__ pos_of, int* gcnt, int* __restrict__ tok_of_slot) {
    LAS float* wl = (LAS float*)lds;
    LAS int* lcnt = (LAS int*)(lds + 32768);
    LAS int* ent = (LAS int*)(lds + 32768 + 64);
    const int tid = otid(), wid = tid >> 6, lane = tid & 63;
    for (int i = tid; i < 1024 * 8; i += NTHR) wl[i] = wrt[i];
    if (tid < 16) lcnt[tid] = 0;
    for (int i = blockIdx.x * NTHR + tid; i < MAXSLOT; i += gridDim.x * NTHR) tok_of_slot[i] = -1;
    __syncthreads();
    f32x4 gv[4], bv[4];
#pragma unroll
    for (int i = 0; i < 4; ++i) { gv[i] = *(const f32x4*)(gam + 4 * lane + 256 * i); bv[i] = *(const f32x4*)(bet + 4 * lane + 256 * i); }
    int kk = 0;
    for (int row = blockIdx.x * 8 + wid; row < NT; row += gridDim.x * 8, ++kk) {
        f32x4 v[4]; float s = 0.f;
#pragma unroll
        for (int i = 0; i < 4; ++i) { v[i] = *(const f32x4*)(Y + (size_t)row * DM + 4 * lane + 256 * i); s += (v[i][0] + v[i][1]) + (v[i][2] + v[i][3]); }
        for (int o = 32; o >= 1; o >>= 1) s += __shfl_xor(s, o);
        const float mu = s * (1.f / DM); float q = 0.f;
#pragma unroll
        for (int i = 0; i < 4; ++i) { const f32x4 d = v[i] - mu; q += (d[0] * d[0] + d[1] * d[1]) + (d[2] * d[2] + d[3] * d[3]); }
        for (int o = 32; o >= 1; o >>= 1) q += __shfl_xor(q, o);
        const float rs = rsqrtf(q * (1.f / DM) + LN_EPS);
        float lg[8];
#pragma unroll
        for (int e = 0; e < 8; ++e) lg[e] = 0.f;
#pragma unroll
        for (int i = 0; i < 4; ++i) { const f32x4 r = (v[i] - mu) * rs * gv[i] + bv[i]; *(f32x4*)(xo + (size_t)row * DM + 4 * lane + 256 * i) = r;
            u32x2 w; w.x = cvt_pk_bf16(r[0], r[1]); w.y = cvt_pk_bf16(r[2], r[3]); *(u32x2*)(xob + (size_t)row * DM + 4 * lane + 256 * i) = w;
#pragma unroll
            for (int j = 0; j < 4; ++j) { const int c = 4 * lane + 256 * i + j; const f32x4 w0 = *(const LAS f32x4*)(wl + c * 8), w1 = *(const LAS f32x4*)(wl + c * 8 + 4);
                lg[0] += r[j] * w0[0]; lg[1] += r[j] * w0[1]; lg[2] += r[j] * w0[2]; lg[3] += r[j] * w0[3]; lg[4] += r[j] * w1[0]; lg[5] += r[j] * w1[1]; lg[6] += r[j] * w1[2]; lg[7] += r[j] * w1[3]; } }
#pragma unroll
        for (int e = 0; e < 8; ++e) { float a = lg[e]; for (int o = 32; o >= 1; o >>= 1) a += __shfl_xor(a, o); lg[e] = a; }
        if (lane == 0) {
            float mx = lg[0];
#pragma unroll
            for (int e = 1; e < 8; ++e) mx = fmaxf(mx, lg[e]);
            float pr[8];
#pragma unroll
            for (int e = 0; e < 8; ++e) pr[e] = expf(lg[e] - mx);
            int e1 = 0; float p1 = pr[0];
#pragma unroll
            for (int e = 1; e < 8; ++e) if (pr[e] > p1) { p1 = pr[e]; e1 = e; }
            int e2 = -1; float p2 = -1.f;
#pragma unroll
            for (int e = 0; e < 8; ++e) if (e != e1 && pr[e] > p2) { p2 = pr[e]; e2 = e; }
            te[row * 2] = e1; te[row * 2 + 1] = e2; tg[row * 2] = p1 / (p1 + p2); tg[row * 2 + 1] = p2 / (p1 + p2);
            const int l1 = atomicAdd((int*)&lcnt[e1], 1), l2 = atomicAdd((int*)&lcnt[e2], 1);
            ent[(kk * 8 + wid) * 2] = e1 | (l1 << 8); ent[(kk * 8 + wid) * 2 + 1] = e2 | (l2 << 8);
        }
    }
    __syncthreads();
    if (tid < 8) lcnt[8 + tid] = atomicAdd(&gcnt[tid], lcnt[tid]);
    __syncthreads();
    if (tid < 128) { const int k2 = tid >> 1, kq = k2 >> 3, w8 = k2 & 7; const int row = blockIdx.x * 8 + w8 + kq * (int)gridDim.x * 8;
        if (row < NT) { const int en = ent[tid]; pos_of[row * 2 + (tid & 1)] = lcnt[8 + (en & 255)] + (en >> 8); } }
    __syncthreads();
}
__device__ __forceinline__ void moe_offsets(const int* gcnt, int (&off)[9]) { int o = 0;
#pragma unroll
    for (int e = 0; e < 8; ++e) { off[e] = o; o += ((ld_agent_i32(gcnt + e) + 255) >> 8) << 8; } off[8] = o; }
__device__ __forceinline__ void phase_moe_map(const int* gcnt, const int* __restrict__ te, const float* __restrict__ tg, const int* __restrict__ pos_of, int* __restrict__ tok_of_slot, float* __restrict__ gate_of_slot, int* __restrict__ slot_of) {
    int off[9]; moe_offsets(gcnt, off);
    for (int i = blockIdx.x * NTHR + otid(); i < NT * 2; i += gridDim.x * NTHR) { const int e = te[i]; int ob = 0;
#pragma unroll
        for (int q = 0; q < 8; ++q) ob = (e == q) ? off[q] : ob;
        const int sl = ob + pos_of[i]; tok_of_slot[sl] = i >> 1; gate_of_slot[sl] = tg[i]; slot_of[i] = sl; }
}
namespace pg8 {
struct MoeSched {
    const char* A; const char* Bt; int off[9]; int rt0, rt1, nN, G, c, gather, ntk, nmini; size_t tstepA, tstepB, estride;
    __device__ __forceinline__ int expert_of(int rt) const { int e = 0;
#pragma unroll
        for (int q = 1; q < 8; ++q) e = (rt * 256 >= off[q]) ? q : e; return e; }
    __device__ __forceinline__ bool next(int i, Unit& u) const {
        int pm, pn; const long L = (long)i * G + c; const int nlong = (rt1 - rt0) * nN;
        if (L < nlong) { tile_order(L, rt1 - rt0, nN, pm, pn);
            const int rt = rt0 + pm; const int e = expert_of(rt);
            u.pm = rt; u.pn = pn; u.arow = rt * 256; u.nt = ntk; u.kind = 0; u.kc = 0; u.A = gather ? A : A + (size_t)pm * tstepA; u.B = Bt + (size_t)e * estride + (size_t)pn * tstepB; return true; }
        const long m = L - nlong; if (m >= nmini) return false;
        const int rtx = (int)(m / 28), kc = (int)((m >> 2) % 7), pn2 = (int)(m & 3); const int rt = rt1 + rtx; const int e = expert_of(rt);
        u.pm = rt; u.pn = pn2; u.arow = rt * 256; u.nt = 8; u.kind = 1; u.kc = kc;
        u.A = A + (size_t)(rt - rt0) * tstepA + (size_t)kc * 1024; u.B = Bt + (size_t)e * estride + (size_t)pn2 * tstepB + (size_t)kc * 1024; return true;
    }
};
struct EpiMoeDown {
    static constexpr bool PERM = true;
    bf16_t* Ys; const float* gate; float* ysp;
    __device__ __forceinline__ void operator()(const f32x4 (&acc)[2][2][4][2], const Unit& u, int wr, int wc, int fr, int fq) const {
        const int row0 = u.pm * BM + wr * 64 + fr, col0 = u.pn * BM + wc * 32 + 8 * fq;
        if (u.kind == 0) {
#pragma unroll
            for (int ai = 0; ai < 2; ++ai)
#pragma unroll
                for (int m = 0; m < 4; ++m) { const int row = row0 + ai * HALF + m * 16; const float gt = gate[row]; bf16_t* rowp = Ys + (size_t)row * DM + col0;
#pragma unroll
                    for (int bj = 0; bj < 2; ++bj) { const f32x4 v0 = acc[ai][bj][m][0] * gt, v1 = acc[ai][bj][m][1] * gt;
                        u32x4 w; w.x = cvt_pk_bf16(v0[0], v0[1]); w.y = cvt_pk_bf16(v0[2], v0[3]); w.z = cvt_pk_bf16(v1[0], v1[1]); w.w = cvt_pk_bf16(v1[2], v1[3]);
                        *(u32x4*)(rowp + bj * HALF) = w; } }
        } else {
            float* base = ysp + ((size_t)u.kc * 2048 + (size_t)(row0 - 32768)) * DM + col0;
#pragma unroll
            for (int ai = 0; ai < 2; ++ai)
#pragma unroll
                for (int m = 0; m < 4; ++m) { float* rowp = base + (size_t)(ai * HALF + m * 16) * DM;
#pragma unroll
                    for (int bj = 0; bj < 2; ++bj) { *(f32x4*)(rowp + bj * HALF) = acc[ai][bj][m][0]; *(f32x4*)(rowp + bj * HALF + 4) = acc[ai][bj][m][1]; } }
        }
    }
};
}
__device__ __forceinline__ f32x4 moe_slot_val(const bf16_t* __restrict__ ys, const float* __restrict__ ysp, const float* __restrict__ gate, int sl, int c) {
    if (sl < 32768) { const u32x2 a = *(const u32x2*)(ys + (size_t)sl * DM + c); return (f32x4){bflo(a.x), bfhi(a.x), bflo(a.y), bfhi(a.y)}; }
    f32x4 acc = *(const f32x4*)(ysp + (size_t)(sl - 32768) * DM + c);
#pragma unroll
    for (int kc = 1; kc < 7; ++kc) acc += *(const f32x4*)(ysp + ((size_t)kc * 2048 + (size_t)(sl - 32768)) * DM + c);
    return acc * gate[sl];
}
__device__ __forceinline__ void phase_final(const float* x3, const bf16_t* __restrict__ ys, const float* __restrict__ ysp, const float* __restrict__ gate, const int* __restrict__ slot_of, const float* __restrict__ gam, const float* __restrict__ bet, float* out) {
    const int wid = otid() >> 6, lane = otid() & 63;
    f32x4 gv[4], bv[4];
#pragma unroll
    for (int i = 0; i < 4; ++i) { gv[i] = *(const f32x4*)(gam + 4 * lane + 256 * i); bv[i] = *(const f32x4*)(bet + 4 * lane + 256 * i); }
    for (int row = blockIdx.x * 8 + wid; row < NT; row += gridDim.x * 8) {
        const int s1 = slot_of[row * 2], s2 = slot_of[row * 2 + 1];
        f32x4 v[4]; float s = 0.f;
#pragma unroll
        for (int i = 0; i < 4; ++i) { const int c = 4 * lane + 256 * i; const f32x4 xv = *(const f32x4*)(x3 + (size_t)row * DM + c);
            const f32x4 y = moe_slot_val(ys, ysp, gate, s1, c) + moe_slot_val(ys, ysp, gate, s2, c);
            v[i] = xv * ALPHA + y; s += (v[i][0] + v[i][1]) + (v[i][2] + v[i][3]); }
        for (int o = 32; o >= 1; o >>= 1) s += __shfl_xor(s, o);
        const float mu = s * (1.f / DM); float q = 0.f;
#pragma unroll
        for (int i = 0; i < 4; ++i) { const f32x4 d = v[i] - mu; q += (d[0] * d[0] + d[1] * d[1]) + (d[2] * d[2] + d[3] * d[3]); }
        for (int o = 32; o >= 1; o >>= 1) q += __shfl_xor(q, o);
        const float rs = rsqrtf(q * (1.f / DM) + LN_EPS);
#pragma unroll
        for (int i = 0; i < 4; ++i) *(f32x4*)(out + (size_t)row * DM + 4 * lane + 256 * i) = (v[i] - mu) * rs * gv[i] + bv[i];
    }
}
namespace attn {
constexpr int D = 128;
constexpr float THR = 8.f;
constexpr bool WSKIP = false;
constexpr float SCALE = 0.08838834764831845f;
constexpr int NW = 8, QBLK = 32, KVBLK = 64, QB = NW * QBLK;
constexpr int SHM_V = KVBLK * D * 2, SHM_K = KVBLK * D * 2;
constexpr int LDS_KM = 2 * SHM_V + 2 * SHM_K + NW * 64 * 4;
constexpr int OSTR = 1024;
typedef short s16x4 __attribute__((ext_vector_type(4)));
typedef float f32x16 __attribute__((ext_vector_type(16)));
template <class A, class Bt> struct same_t { static constexpr bool v = false; };
template <class A> struct same_t<A, A> { static constexpr bool v = true; };
#define KSWZ(row, colB) ((row) * 256 + ((colB) ^ (((row) & 7) << 4)))
#define SBAR() __builtin_amdgcn_sched_barrier(0)
__device__ __forceinline__ int v_st(int k, int c) { const int kk = (k & ~0xC) | ((k & 4) << 1) | ((k & 8) >> 1); return ((kk >> 3) * 4 + (c >> 5)) * 512 + ((kk & 7) * 32 + (c & 31)) * 2; }
__device__ __forceinline__ int v_rd_base(int lane) { return ((lane & 3) << 3) | (((lane >> 2) & 3) << 6) | (((lane >> 4) & 1) << 5) | (((lane >> 5) & 1) << 8); }
constexpr int v_rd_off(int d0, int ks, int half) { return d0 * 512 + ks * 4096 + half * 2048; }
__device__ __forceinline__ int crow(int r, int hi) { return (r & 3) + 8 * (r >> 2) + 4 * hi; }
__device__ __forceinline__ unsigned cvtpk(float lo, float hi) {
    unsigned r; asm volatile("v_cvt_pk_bf16_f32 %0, %1, %2" : "=v"(r) : "v"(lo), "v"(hi)); return r;
}
__device__ __forceinline__ bf16x8 pack8(f32x4 a, f32x4 b) {
    u32x4 w = {cvtpk(a[0], a[1]), cvtpk(a[2], a[3]), cvtpk(b[0], b[1]), cvtpk(b[2], b[3])};
    return *reinterpret_cast<bf16x8*>(&w);
}
template <class T> __device__ __forceinline__ bf16x8 load8(const T* p) {
    if constexpr (same_t<T, float>::v) { return pack8(*(const f32x4*)p, *(const f32x4*)(p + 4)); }
    else { return *reinterpret_cast<const bf16x8*>(p); }
}
__device__ __forceinline__ void mask_tile(f32x16& p0, f32x16& p1, int dq, unsigned W) {
    const float NEG = -__builtin_inff();
#pragma unroll
    for (int r = 0; r < 16; ++r) {
        const int c = (r & 3) + 8 * (r >> 2);
        if ((unsigned)(dq - c) >= W) p0[r] = NEG;
        if ((unsigned)(dq - c - 32) >= W) p1[r] = NEG;
    }
}
__device__ __forceinline__ void partialSM(f32x16& p0, f32x16& p1, float& m_reg, float& mn, float& alpha) {
    float pmax = p0[0]; for (int r = 1; r < 16; ++r) pmax = fmaxf(pmax, p0[r]); for (int r = 0; r < 16; ++r) pmax = fmaxf(pmax, p1[r]);
    { auto rr = __builtin_amdgcn_permlane32_swap(__float_as_uint(pmax), __float_as_uint(pmax), false, false);
      pmax = fmaxf(__uint_as_float(rr[0]), __uint_as_float(rr[1])); }
    constexpr float C2 = 1.4426950408889634f * SCALE;
    if (__builtin_expect(__all((pmax - m_reg) * SCALE <= THR), 1)) { mn = m_reg; alpha = 1.f; }
    else { mn = fmaxf(m_reg, pmax); alpha = __builtin_amdgcn_exp2f((m_reg - mn) * C2); m_reg = mn; }
    const float mnL = -mn * C2;
    for (int r = 0; r < 16; ++r) p0[r] = fmaf(p0[r], C2, mnL); for (int r = 0; r < 16; ++r) p1[r] = fmaf(p1[r], C2, mnL);
    for (int r = 0; r < 16; ++r) p0[r] = __builtin_amdgcn_exp2f(p0[r]);
}
__device__ __forceinline__ void finishSM(f32x16& p0, f32x16& p1, float alpha, float& l_reg, bf16x8& pa0, bf16x8& pa1, bf16x8& pa2, bf16x8& pa3) {
    for (int r = 0; r < 16; ++r) p1[r] = __builtin_amdgcn_exp2f(p1[r]);
    float ps = 0; for (int r = 0; r < 16; ++r) ps += p0[r]; for (int r = 0; r < 16; ++r) ps += p1[r];
    { auto rr = __builtin_amdgcn_permlane32_swap(__float_as_uint(ps), __float_as_uint(ps), false, false);
      ps = __uint_as_float(rr[0]) + __uint_as_float(rr[1]); }
    l_reg = l_reg * alpha + ps;
#define PK4(P, B_, OUT) do { unsigned a0 = cvtpk(P[B_+0], P[B_+1]), a1 = cvtpk(P[B_+2], P[B_+3]);                          \
        unsigned b0 = cvtpk(P[B_+4], P[B_+5]), b1 = cvtpk(P[B_+6], P[B_+7]);                                             \
        auto r0 = __builtin_amdgcn_permlane32_swap(a0, b0, false, false); auto r1 = __builtin_amdgcn_permlane32_swap(a1, b1, false, false); \
        u32x4 w = {r0[0], r1[0], r0[1], r1[1]}; OUT = *reinterpret_cast<bf16x8*>(&w); } while (0)
    PK4(p0, 0, pa0); PK4(p0, 8, pa1); PK4(p1, 0, pa2); PK4(p1, 8, pa3);
#undef PK4
}
template <int KB, bool SK>
__device__ __forceinline__ void qkt(f32x16& p0, f32x16& p1, const char* K_lds, int r32, int hi, const bf16x8* qr, bool act) {
    if (SK && !act) { const float NEG = -__builtin_inff();
#pragma unroll
        for (int r = 0; r < 16; ++r) { p0[r] = NEG; p1[r] = NEG; } return; }
    p0 = f32x16{}; p1 = f32x16{};
    const char* kb[4];
#pragma unroll
    for (int dd = 0; dd < 4; ++dd) kb[dd] = K_lds + KB * SHM_K + KSWZ(r32, (dd * 16 + hi * 8) * 2);
#pragma unroll
    for (int d0 = 0; d0 < 8; ++d0) { const char* a = kb[d0 & 3] + (d0 >> 2) * 128;
        bf16x8 b0 = *reinterpret_cast<const bf16x8*>(a);
        bf16x8 b1 = *reinterpret_cast<const bf16x8*>(a + 32 * 256);
        p0 = __builtin_amdgcn_mfma_f32_32x32x16_bf16(b0, qr[d0], p0, 0, 0, 0);
        p1 = __builtin_amdgcn_mfma_f32_32x32x16_bf16(b1, qr[d0], p1, 0, 0, 0); }
}
template <int VB, bool SK>
__device__ __forceinline__ void pv_tile(f32x16* o, int vb0, bf16x8 pa0, bf16x8 pa1, bf16x8 pa2, bf16x8 pa3, bool act) {
    if (SK && !act) return;
#define TRRD(dst, off) asm volatile("ds_read_b64_tr_b16 %0, %1 offset:%2" : "=&v"(dst) : "v"(vb0), "i"(off) : "memory")
#define PV_D0(d0) do { s16x4 l0, l1, l2, l3, h0, h1, h2, h3; constexpr int b_ = VB * SHM_V + v_rd_off(d0, 0, 0);     \
        TRRD(l0, b_); TRRD(h0, b_ + 2048); TRRD(l1, b_ + 4096); TRRD(h1, b_ + 6144); TRRD(l2, b_ + 8192); TRRD(h2, b_ + 10240); TRRD(l3, b_ + 12288); TRRD(h3, b_ + 14336); \
        asm volatile("s_waitcnt lgkmcnt(0)" ::: "memory"); SBAR();                 \
        o[d0] = __builtin_amdgcn_mfma_f32_32x32x16_bf16(pa0, (bf16x8){l0[0], l0[1], l0[2], l0[3], h0[0], h0[1], h0[2], h0[3]}, o[d0], 0, 0, 0);   \
        o[d0] = __builtin_amdgcn_mfma_f32_32x32x16_bf16(pa1, (bf16x8){l1[0], l1[1], l1[2], l1[3], h1[0], h1[1], h1[2], h1[3]}, o[d0], 0, 0, 0);   \
        o[d0] = __builtin_amdgcn_mfma_f32_32x32x16_bf16(pa2, (bf16x8){l2[0], l2[1], l2[2], l2[3], h2[0], h2[1], h2[2], h2[3]}, o[d0], 0, 0, 0);   \
        o[d0] = __builtin_amdgcn_mfma_f32_32x32x16_bf16(pa3, (bf16x8){l3[0], l3[1], l3[2], l3[3], h3[0], h3[1], h3[2], h3[3]}, o[d0], 0, 0, 0); } while (0)
    PV_D0(0); PV_D0(1); PV_D0(2); PV_D0(3);
#undef PV_D0
#undef TRRD
}

template <class TIn, class TOut> struct BlockRef { const TIn* Q; const TIn* K; const TIn* V; TOut* O; const float* KM; int P0; int pad; };
template <class TIn> struct Seam {
    bf16x8 qr[8];
    bf16x8 st_v0, st_v1, st_k0, st_k1; f32x4 sf0, sf1, sf2, sf3;
    f32x4 tq[16];
};
__device__ __forceinline__ int swa_jlo(int P0, int W) { const int lowk = P0 - W + 1; return lowk > 0 ? lowk / KVBLK : 0; }
#define ROW(p, k0, rr) ((p) + (size_t)((k0) + (rr)) * D + sc)
#define VMW() asm volatile("s_waitcnt vmcnt(0)" ::: "memory")
#define VMWN(n) asm volatile("s_waitcnt vmcnt(%0)" :: "i"(n) : "memory")
#define SLOAD_H(Kp, Vp, k0) do { S.st_v0 = load8<TIn>(ROW(Vp, k0, sr)); S.st_v1 = load8<TIn>(ROW(Vp, k0, 32 + sr));              \
                         S.st_k0 = load8<TIn>(ROW(Kp, k0, sr)); S.st_k1 = load8<TIn>(ROW(Kp, k0, 32 + sr)); } while (0)
#define SWRITE_HK(bf) do { *(bf16x8*)(K_lds + (bf) * SHM_K + kws) = S.st_k0; *(bf16x8*)(K_lds + (bf) * SHM_K + kws + 32 * 256) = S.st_k1; } while (0)
#define SWRITE_HV(bf) do { *(bf16x8*)(V_lds + (bf) * SHM_V + vst0) = S.st_v0; *(bf16x8*)(V_lds + (bf) * SHM_V + vst1) = S.st_v1; } while (0)
#define SWRITE_H(bf) do { SWRITE_HV(bf); SWRITE_HK(bf); } while (0)
#define SLOAD_F(p, k0) do { S.sf0 = *(const f32x4*)ROW(p, k0, sr); S.sf1 = *(const f32x4*)(ROW(p, k0, sr) + 4);                \
                            S.sf2 = *(const f32x4*)ROW(p, k0, 32 + sr); S.sf3 = *(const f32x4*)(ROW(p, k0, 32 + sr) + 4); } while (0)
#define SWRITE_KF(bf) do { *(bf16x8*)(K_lds + (bf) * SHM_K + kws) = pack8(S.sf0, S.sf1); *(bf16x8*)(K_lds + (bf) * SHM_K + kws + 32 * 256) = pack8(S.sf2, S.sf3); } while (0)
#define SWRITE_VF(bf) do { *(bf16x8*)(V_lds + (bf) * SHM_V + vst0) = pack8(S.sf0, S.sf1); *(bf16x8*)(V_lds + (bf) * SHM_V + vst1) = pack8(S.sf2, S.sf3); } while (0)
template <class TIn, class TOut>
__device__ __forceinline__ void causal_swa_prime(const BlockRef<TIn, TOut>& cur, int W, char* lds, Seam<TIn>& S) {
    constexpr bool F32 = same_t<TIn, float>::v;
    const int tid = otid(), wid = __builtin_amdgcn_readfirstlane(tid >> 6), lane = tid & 63, r32 = lane & 31, hi = lane >> 5;
    const int sr = tid >> 4, sc = (tid & 15) * 8, kws = KSWZ(sr, sc * 2); char* K_lds = lds + 2 * SHM_V;
    const int kb0 = swa_jlo(cur.P0, W) * KVBLK;
    for (int d0 = 0; d0 < 8; ++d0) S.qr[d0] = load8<TIn>(cur.Q + (size_t)(wid * QBLK + r32) * D + d0 * 16 + hi * 8);
    if constexpr (F32) { SLOAD_F((const float*)cur.K, kb0); VMW(); SWRITE_KF(0); SBAR(); SLOAD_F((const float*)cur.V, kb0); }
    else { SLOAD_H(cur.K, cur.V, kb0); VMW(); SWRITE_HK(0); }
    __syncthreads();
}
template <class TIn, class TOut>
__device__ __forceinline__ void causal_swa_block(const BlockRef<TIn, TOut>& cur, const BlockRef<TIn, TOut>& nxt, int skv, int W, char* lds, Seam<TIn>& S) {
    constexpr bool F32 = same_t<TIn, float>::v;
    const int tid = otid(), wid = __builtin_amdgcn_readfirstlane(tid >> 6), lane = tid & 63, r32 = lane & 31, hi = lane >> 5;
    const int j_lo = swa_jlo(cur.P0, W);
    int j_hi = (cur.P0 + QB - 1) / KVBLK + 1; if (j_hi > skv / KVBLK) j_hi = skv / KVBLK;
    const int NT = j_hi - j_lo;
    const int kbn = swa_jlo(nxt.P0, W) * KVBLK;
    const int qlo = cur.P0 + wid * QBLK, qm = qlo + r32 - 4 * hi;
    char* V_lds = lds; char* K_lds = lds + 2 * SHM_V;
    float* ws = (float*)(lds + 2 * SHM_V + 2 * SHM_K) + wid * 64; float* li_l = ws, * al_l = ws + 32;
    float m_reg = -1e30f, l_reg = 0; f32x16 o[4] = {};
    const int sr = tid >> 4, sc = (tid & 15) * 8, vst0 = v_st(sr, sc), vst1 = v_st(32 + sr, sc), kws = KSWZ(sr, sc * 2);
    const int vb0 = (int)(uintptr_t)V_lds + v_rd_base(lane);
    const TIn* Kh = cur.K; const TIn* Vh = cur.V;
    const int qblk = cur.P0 >> 8; unsigned selmask = 0u;
    {
        float* kml = (float*)(lds + LDS_KM);
        for (int i = tid; i < 8 * 128; i += 512) { const int n = i >> 7, d = i & 127; kml[i] = (cur.KM[(n * 2 + 0) * 128 + d] + cur.KM[(n * 2 + 1) * 128 + d]) * (1.f / 256.f); }
        __syncthreads();
        float gs[8];
#pragma unroll
        for (int n = 0; n < 8; ++n) gs[n] = -3.0e38f;
#pragma unroll
        for (int n = 0; n < 7; ++n) if (n < qblk) { float a = 0.f;
#pragma unroll
            for (int d0 = 0; d0 < 8; ++d0) { const f32x4 k0 = *(const f32x4*)(kml + n * 128 + d0 * 16 + hi * 8), k1 = *(const f32x4*)(kml + n * 128 + d0 * 16 + hi * 8 + 4); const bf16x8 qv = S.qr[d0];
                a += __uint_as_float(((unsigned)(unsigned short)qv[0]) << 16) * k0[0] + __uint_as_float(((unsigned)(unsigned short)qv[1]) << 16) * k0[1]
                   + __uint_as_float(((unsigned)(unsigned short)qv[2]) << 16) * k0[2] + __uint_as_float(((unsigned)(unsigned short)qv[3]) << 16) * k0[3]
                   + __uint_as_float(((unsigned)(unsigned short)qv[4]) << 16) * k1[0] + __uint_as_float(((unsigned)(unsigned short)qv[5]) << 16) * k1[1]
                   + __uint_as_float(((unsigned)(unsigned short)qv[6]) << 16) * k1[2] + __uint_as_float(((unsigned)(unsigned short)qv[7]) << 16) * k1[3]; }
            a += __shfl_xor(a, 32); gs[n] = a; }
        if (qblk <= 3) selmask = (1u << qblk) - 1u;
        else {
#pragma unroll
            for (int r = 0; r < 3; ++r) { float bv = -3.0e38f; int best = 0;
#pragma unroll
                for (int n = 0; n < 7; ++n) { const bool ok = (n < qblk) && (((selmask >> n) & 1u) == 0u) && (gs[n] > bv); bv = ok ? gs[n] : bv; best = ok ? n : best; }
                selmask |= 1u << best; }
        }
    }
#define RESC(a) do { if (__any((a) < 1.f)) { if (hi == 0) al_l[r32] = (a); asm volatile("s_waitcnt lgkmcnt(0)" ::: "memory");              \
                     for (int d_ = 0; d_ < 4; ++d_) for (int r = 0; r < 16; ++r) o[d_][r] *= al_l[crow(r, hi)]; } } while (0)
#define KBASE(t) ((j_lo + (t)) * KVBLK)
#define ACT(t) (KBASE(t) <= qlo + QBLK - 1 && KBASE(t) + KVBLK - 1 >= qlo - W + 1)
#define MASKT(P0_, P1_, t) do { const int kb_ = KBASE(t); if ((!SK || ACT(t)) && (kb_ + KVBLK - 1 > qlo || kb_ <= qlo + QBLK - 1 - W)) mask_tile(P0_, P1_, qm - kb_, (unsigned)W); \
        const int nb_ = kb_ >> 8; if (nb_ < qblk) { const bool drop_ = ((selmask >> nb_) & 1u) == 0u; const float NEG_ = -__builtin_inff(); \
            _Pragma("unroll") for (int r_ = 0; r_ < 16; ++r_) { P0_[r_] = drop_ ? NEG_ : P0_[r_]; P1_[r_] = drop_ ? NEG_ : P1_[r_]; } } } while (0)
    constexpr int NQL = F32 ? 16 : 8;
    constexpr bool SK = WSKIP && !F32;
#define SEAM_K0() do { VMWN(NQL); if constexpr (F32) { SWRITE_KF(0); SBAR(); SLOAD_F((const float*)nxt.V, kbn); } else { SWRITE_HK(0); } SBAR(); } while (0)
    f32x16 pA0, pA1, pB0, pB1; float mnA, mnB, alA, alB; bf16x8 pa0, pa1, pa2, pa3;
    if constexpr (F32) { VMW(); SWRITE_VF(0); SBAR(); } else { SWRITE_HV(0); SBAR(); }
    if (NT > 1) { if constexpr (F32) SLOAD_F((const float*)Kh, KBASE(1)); else SLOAD_H(Kh, Vh, KBASE(1)); }
    SBAR(); qkt<0, SK>(pA0, pA1, K_lds, r32, hi, S.qr, ACT(0));
    if constexpr (F32) { if (NT > 1) { VMW(); SWRITE_KF(1); SBAR(); SLOAD_F((const float*)Vh, KBASE(1)); } }
    MASKT(pA0, pA1, 0); partialSM(pA0, pA1, m_reg, mnA, alA);
    if (NT > 1) { VMW(); if constexpr (F32) { SWRITE_VF(1); SBAR(); if (NT > 2) SLOAD_F((const float*)Kh, KBASE(2)); } else SWRITE_H(1); }
    __syncthreads();
#define HALF_STEP(PX0, PX1, mnX, alX, PY0, PY1, alY, t, KB, VB, SB) do {                                                      \
        SBAR(); qkt<KB, SK>(PX0, PX1, K_lds, r32, hi, S.qr, ACT(t));                                             \
        finishSM(PY0, PY1, alY, l_reg, pa0, pa1, pa2, pa3); SBAR();                                                           \
        if ((t) + 1 < NT) { if constexpr (F32) { VMW(); SWRITE_KF(SB); SBAR(); SLOAD_F((const float*)Vh, KBASE((t) + 1)); }  \
                            else { SLOAD_H(Kh, Vh, KBASE((t) + 1)); } SBAR(); }                                               \
        pv_tile<VB, SK>(o, vb0, pa0, pa1, pa2, pa3, ACT((t) - 1)); MASKT(PX0, PX1, (t)); partialSM(PX0, PX1, m_reg, mnX, alX);                                        \
        __syncthreads();                                                                                                      \
        if ((t) + 1 < NT) { VMW(); if constexpr (F32) { SWRITE_VF(SB); SBAR(); if ((t) + 2 < NT) SLOAD_F((const float*)Kh, KBASE((t) + 2)); } \
                            else { SWRITE_H(SB); } }                                                                          \
        RESC(alX); __syncthreads(); } while (0)
    for (int t = 1; t + 1 < NT; t += 2) {
        HALF_STEP(pB0, pB1, mnB, alB, pA0, pA1, alA, t, 1, 0, 0);
        HALF_STEP(pA0, pA1, mnA, alA, pB0, pB1, alB, t + 1, 0, 1, 1);
    }
    const bool even = (NT & 1) == 0;
    if (even) { SBAR(); qkt<1, SK>(pB0, pB1, K_lds, r32, hi, S.qr, ACT(NT - 1)); SBAR(); }
#define QROW(e) (nxt.Q + (size_t)(wid * QBLK + r32) * D + ((e) >> 1) * 16 + hi * 8 + ((e) & 1) * 4)
    if constexpr (F32) { SLOAD_F((const float*)nxt.K, kbn); SBAR();
#pragma unroll
        for (int e = 0; e < 8; ++e) S.tq[e] = *(const f32x4*)QROW(e); }
    else { SLOAD_H(nxt.K, nxt.V, kbn); SBAR();
#pragma unroll
        for (int d0 = 0; d0 < 8; ++d0) S.qr[d0] = load8<TIn>(nxt.Q + (size_t)(wid * QBLK + r32) * D + d0 * 16 + hi * 8); }
    SBAR();
    finishSM(pA0, pA1, alA, l_reg, pa0, pa1, pa2, pa3); SBAR();
    if constexpr (F32) {
#pragma unroll
        for (int e = 8; e < 16; ++e) S.tq[e] = *(const f32x4*)QROW(e); SBAR(); }
#undef QROW
    pv_tile<0, SK>(o, vb0, pa0, pa1, pa2, pa3, ACT(even ? NT - 2 : NT - 1));
    if (even) { MASKT(pB0, pB1, NT - 1); partialSM(pB0, pB1, m_reg, mnB, alB); __syncthreads(); RESC(alB);
        finishSM(pB0, pB1, alB, l_reg, pa0, pa1, pa2, pa3); SBAR(); pv_tile<1, SK>(o, vb0, pa0, pa1, pa2, pa3, ACT(NT - 1)); }
    SBAR(); SEAM_K0();
    if (hi == 0) li_l[r32] = l_reg; asm volatile("s_waitcnt lgkmcnt(0)" ::: "memory");
    float rli[16];
#pragma unroll
    for (int r = 0; r < 16; ++r) rli[r] = __builtin_amdgcn_rcpf(li_l[crow(r, hi)]);
    TOut* Ow = cur.O + (size_t)(wid * QBLK) * OSTR;
#pragma unroll
    for (int r = 0; r < 16; ++r) { const int orow = crow(r, hi);
#pragma unroll
        for (int d0 = 0; d0 < 4; ++d0) { const float v = o[d0][r] * rli[r];
            if constexpr (same_t<TOut, float>::v) { Ow[(size_t)orow * OSTR + d0 * 32 + r32] = v; }
            else { const float vn = __shfl_xor(v, 1);
                   if ((r32 & 1) == 0) *(unsigned*)(Ow + (size_t)orow * OSTR + d0 * 32 + r32) = cvtpk(v, vn); } } }
    if constexpr (F32) {
#pragma unroll
        for (int d0 = 0; d0 < 8; ++d0) S.qr[d0] = pack8(S.tq[2 * d0], S.tq[2 * d0 + 1]); }
    __syncthreads();
#undef RESC
#undef KBASE
#undef ACT
#undef MASKT
#undef SEAM_K0
#undef HALF_STEP
}
#undef ROW
#undef VMW
#undef VMWN
#undef SLOAD_H
#undef SWRITE_HK
#undef SWRITE_HV
#undef SWRITE_H
#undef SLOAD_F
#undef SWRITE_KF
#undef SWRITE_VF
}

__device__ __forceinline__ void phase_attn(LAS unsigned char* lds_, const bf16_t* __restrict__ Qb, const bf16_t* __restrict__ Kb, const bf16_t* __restrict__ Vb, const float* __restrict__ kmp, bf16_t* __restrict__ att) {
    using namespace attn;
    char* lds = (char*)lds_;
    typedef BlockRef<bf16_t, bf16_t> Ref;
    const int total = 256, stride = gridDim.x;
    int L = blockIdx.x; if (L >= total) return;
    auto mkref = [&](int Li, int pass) { const int bh = (Li & 7) + 8 * (Li >> 5), x = (Li >> 3) & 3; const int qb = pass ? 7 - x : x; const int b = bh >> 3, h = bh & 7;
        Ref r; r.Q = Qb + ((size_t)bh * SEQ + (size_t)qb * QB) * D; r.K = Kb + (size_t)bh * SEQ * D; r.V = Vb + (size_t)bh * SEQ * D;
        r.O = att + ((size_t)(b * SEQ + qb * QB) * OSTR + h * D); r.KM = kmp + (size_t)bh * 8 * 2 * 128; r.P0 = qb * QB; r.pad = 0; return r; };
    int pass = 0; Ref cur = mkref(L, 0);
    Seam<bf16_t> S;
    const int W = 0x7fffffff;
    causal_swa_prime<bf16_t, bf16_t>(cur, W, lds, S);
    for (;;) {
        const bool more_pass = pass == 0, more_item = L + stride < total, last = !more_pass && !more_item;
        int passn = pass + 1, Ln = L;
        if (!more_pass) { passn = 0; Ln = more_item ? L + stride : L; }
        const Ref nxt = last ? cur : mkref(Ln, passn);
        causal_swa_block<bf16_t, bf16_t>(cur, nxt, SEQ, W, lds, S);
        if (last) break;
        cur = nxt; pass = passn; L = Ln;
    }
}
template <int CTRL> __device__ __forceinline__ float dpp_mov(float x) { return __int_as_float(__builtin_amdgcn_update_dpp(0, __float_as_int(x), CTRL, 0xf, 0xf, false)); }
__device__ __forceinline__ float red16(float x) { x += dpp_mov<0x128>(x); x += dpp_mov<0x124>(x); x += dpp_mov<0x122>(x); x += dpp_mov<0x121>(x); return x; }

__device__ __forceinline__ void phase_dn(LAS unsigned char* lds, const bf16_t* __restrict__ proj, const float* __restrict__ convw, const float* __restrict__ gl, const float* __restrict__ betal, float* __restrict__ og) {
    LAS float* KQ = (LAS float*)lds;
    LAS float* VL = (LAS float*)(lds + 65536);
    LAS float* SC = (LAS float*)(lds + 73728);
    LAS float* OL = (LAS float*)(lds + 74752);
    const int tid = otid(), lane = tid & 63, wid = tid >> 6;
    for (int L = blockIdx.x; L < 256; L += gridDim.x) {
    const int bh = (L & 7) + 8 * (L >> 5), s4 = (L >> 3) & 3, b = bh >> 3, h = bh & 7;
    const int g = tid & 31, run = tid >> 5; const bool isq = g < 16;
    const int chqk = (isq ? 0 : 1024) + h * 128 + 8 * (g & 15);
    const int gv = tid & 3, tv = tid >> 2; const int chv = 2048 + h * 128 + 32 * s4 + 8 * gv;
    float wqk[4][8], wv[4][8];
#pragma unroll
    for (int j = 0; j < 4; ++j)
#pragma unroll
        for (int e = 0; e < 8; ++e) { wqk[j][e] = convw[j * 3072 + chqk + e]; wv[j][e] = convw[j * 3072 + chv + e]; }
    const size_t tok0 = (size_t)b * SEQ;
    u32x4 rq[7], rv[4];
    auto load_chunk = [&](int t0) {
#pragma unroll
        for (int i = 0; i < 7; ++i) { const int s = t0 + 4 * run - 3 + i; rq[i] = (s >= 0) ? *(const u32x4*)(proj + (tok0 + s) * 4096 + chqk) : (u32x4){0u, 0u, 0u, 0u}; }
        if (tid < 256) {
#pragma unroll
            for (int i = 0; i < 4; ++i) { const int s = t0 + tv - 3 + i; rv[i] = (s >= 0) ? *(const u32x4*)(proj + (tok0 + s) * 4096 + chv) : (u32x4){0u, 0u, 0u, 0u}; } }
    };
    auto unpack8 = [](const u32x4& w, float (&f)[8]) { f[0] = bflo(w.x); f[1] = bfhi(w.x); f[2] = bflo(w.y); f[3] = bfhi(w.y); f[4] = bflo(w.z); f[5] = bfhi(w.z); f[6] = bflo(w.w); f[7] = bfhi(w.w); };
    const int r = lane & 15, jc = wid * 4 + (lane >> 4);
    float St[8];
#pragma unroll
    for (int i = 0; i < 8; ++i) St[i] = 0.f;
    load_chunk(0);
    for (int n = 0; n < SEQ / 64; ++n) {
        const int t0 = n * 64;
        {
            float xr[7][8];
#pragma unroll
            for (int i = 0; i < 7; ++i) unpack8(rq[i], xr[i]);
#pragma unroll
            for (int u = 0; u < 4; ++u) { float y[8]; float ss = 0.f;
#pragma unroll
                for (int e = 0; e < 8; ++e) { float a = wqk[0][e] * xr[u][e]; a = fmaf(wqk[1][e], xr[u + 1][e], a); a = fmaf(wqk[2][e], xr[u + 2][e], a); a = fmaf(wqk[3][e], xr[u + 3][e], a);
                    y[e] = a * __builtin_amdgcn_rcpf(1.f + __expf(-a)); ss = fmaf(y[e], y[e], ss); }
                ss = red16(ss);
                const float sc = rsqrtf(ss + 1e-6f) * (isq ? 0.08838834764831845f : 1.f);
                const int t = 4 * run + u; LAS float* dst = KQ + t * 256 + (isq ? 128 : 0) + (g & 15) * 4;
                *(LAS f32x4*)dst = (f32x4){y[0] * sc, y[1] * sc, y[2] * sc, y[3] * sc}; *(LAS f32x4*)(dst + 64) = (f32x4){y[4] * sc, y[5] * sc, y[6] * sc, y[7] * sc}; }
            if (tid < 256) { float xv[4][8];
#pragma unroll
                for (int i = 0; i < 4; ++i) unpack8(rv[i], xv[i]);
                float y[8];
#pragma unroll
                for (int e = 0; e < 8; ++e) { float a = wv[0][e] * xv[0][e]; a = fmaf(wv[1][e], xv[1][e], a); a = fmaf(wv[2][e], xv[2][e], a); a = fmaf(wv[3][e], xv[3][e], a); y[e] = a * __builtin_amdgcn_rcpf(1.f + __expf(-a)); }
                *(LAS f32x4*)(VL + tv * 32 + 8 * gv) = (f32x4){y[0], y[1], y[2], y[3]}; *(LAS f32x4*)(VL + tv * 32 + 8 * gv + 4) = (f32x4){y[4], y[5], y[6], y[7]}; }
            else if (tid < 320) { const int t = tid - 256; const size_t ix = (tok0 + t0 + t) * 8 + h; SC[t * 4 + 0] = __expf(gl[ix]); SC[t * 4 + 1] = betal[ix]; }
        }
        __syncthreads();
        {
            const int t = tid >> 3, p8 = tid & 7; float a = 0.f;
#pragma unroll
            for (int rr = 0; rr < 2; ++rr)
#pragma unroll
                for (int pp = 0; pp < 2; ++pp) { const f32x4 kk = *(const LAS f32x4*)(KQ + t * 256 + pp * 64 + (2 * p8 + rr) * 4), qq = *(const LAS f32x4*)(KQ + t * 256 + 128 + pp * 64 + (2 * p8 + rr) * 4);
                    a += kk[0] * qq[0] + kk[1] * qq[1] + kk[2] * qq[2] + kk[3] * qq[3]; }
            a += __shfl_xor(a, 1); a += __shfl_xor(a, 2); a += __shfl_xor(a, 4);
            if (p8 == 0) SC[t * 4 + 2] = a;
        }
        __syncthreads();
        if (n + 1 < SEQ / 64) load_chunk(t0 + 64);
        {
            f32x4 k0 = *(const LAS f32x4*)(KQ + r * 4), k1 = *(const LAS f32x4*)(KQ + 64 + r * 4), q0 = *(const LAS f32x4*)(KQ + 128 + r * 4), q1 = *(const LAS f32x4*)(KQ + 192 + r * 4);
            f32x4 sc = *(const LAS f32x4*)(SC); float vj = VL[jc];
#pragma unroll 4
            for (int t = 0; t < 64; ++t) {
                const int tn = (t + 1) & 63;
                const f32x4 k0n = *(const LAS f32x4*)(KQ + tn * 256 + r * 4), k1n = *(const LAS f32x4*)(KQ + tn * 256 + 64 + r * 4);
                const f32x4 q0n = *(const LAS f32x4*)(KQ + tn * 256 + 128 + r * 4), q1n = *(const LAS f32x4*)(KQ + tn * 256 + 192 + r * 4);
                const f32x4 scn = *(const LAS f32x4*)(SC + tn * 4); const float vjn = VL[tn * 32 + jc];
                float kd = k0[0] * St[0], qd = q0[0] * St[0];
                kd = fmaf(k0[1], St[1], kd); qd = fmaf(q0[1], St[1], qd); kd = fmaf(k0[2], St[2], kd); qd = fmaf(q0[2], St[2], qd); kd = fmaf(k0[3], St[3], kd); qd = fmaf(q0[3], St[3], qd);
                kd = fmaf(k1[0], St[4], kd); qd = fmaf(q1[0], St[4], qd); kd = fmaf(k1[1], St[5], kd); qd = fmaf(q1[1], St[5], qd); kd = fmaf(k1[2], St[6], kd); qd = fmaf(q1[2], St[6], qd); kd = fmaf(k1[3], St[7], kd); qd = fmaf(q1[3], St[7], qd);
                kd = red16(kd); qd = red16(qd);
                const float eg = sc[0], vn = sc[1] * (vj - eg * kd);
                St[0] = fmaf(k0[0], vn, eg * St[0]); St[1] = fmaf(k0[1], vn, eg * St[1]); St[2] = fmaf(k0[2], vn, eg * St[2]); St[3] = fmaf(k0[3], vn, eg * St[3]);
                St[4] = fmaf(k1[0], vn, eg * St[4]); St[5] = fmaf(k1[1], vn, eg * St[5]); St[6] = fmaf(k1[2], vn, eg * St[6]); St[7] = fmaf(k1[3], vn, eg * St[7]);
                if (r == 0) OL[t * 32 + jc] = fmaf(eg, qd, sc[2] * vn);
                k0 = k0n; k1 = k1n; q0 = q0n; q1 = q1n; sc = scn; vj = vjn;
            }
        }
        __syncthreads();
        {
            const int t = tid >> 3, c4 = (tid & 7) * 4;
            *(f32x4*)(og + (tok0 + t0 + t) * DM + h * 128 + s4 * 32 + c4) = *(const LAS f32x4*)(OL + t * 32 + c4);
        }
    }
    __syncthreads();
    }
}
__device__ __forceinline__ void phase_dn_post(const float* __restrict__ o, const bf16_t* __restrict__ proj, const float* __restrict__ norm_w, bf16_t* __restrict__ ogb) {
    const int wid = otid() >> 6, lane = otid() & 63;
    const f32x4 nw = *(const f32x4*)(norm_w + ((4 * lane) & 127));
    for (int row = blockIdx.x * 8 + wid; row < NT; row += gridDim.x * 8) {
#pragma unroll
        for (int i = 0; i < 4; ++i) { const int c = 4 * lane + 256 * i; const f32x4 v = *(const f32x4*)(o + (size_t)row * DM + c);
            float ss = (v[0] * v[0] + v[1] * v[1]) + (v[2] * v[2] + v[3] * v[3]);
            ss += __shfl_xor(ss, 1); ss += __shfl_xor(ss, 2); ss += __shfl_xor(ss, 4); ss += __shfl_xor(ss, 8); ss += __shfl_xor(ss, 16);
            const float rr = rsqrtf(ss * (1.f / 128.f) + 1e-6f);
            const u32x2 gw = *(const u32x2*)(proj + (size_t)row * 4096 + 3072 + c);
            const float g0 = bflo(gw.x), g1 = bfhi(gw.x), g2 = bflo(gw.y), g3 = bfhi(gw.y);
            const float r0 = v[0] * rr * nw[0] * (g0 / (1.f + __expf(-g0))), r1 = v[1] * rr * nw[1] * (g1 / (1.f + __expf(-g1))), r2 = v[2] * rr * nw[2] * (g2 / (1.f + __expf(-g2))), r3 = v[3] * rr * nw[3] * (g3 / (1.f + __expf(-g3)));
            u32x2 w; w.x = cvt_pk_bf16(r0, r1); w.y = cvt_pk_bf16(r2, r3); *(u32x2*)(ogb + (size_t)row * DM + c) = w; }
    }
}
namespace dn {
typedef float f32x16 __attribute__((ext_vector_type(16)));
constexpr int PK = 272, PT = 144;
constexpr int O_KR = 0, O_QR = 17408, O_KT = 34816, O_VT = 53248, O_LM = 71680, O_TK = 89088, O_TV = 98304, O_DM = 107520, O_SC = 111616;
constexpr int C_WN = 0, C_QD = 16384, C_KD = 32768, C_P = 49152, C_U = 55296, C_EG = 71680, CHUNK_BYTES = 71936;
__device__ __forceinline__ int crow(int r, int hi) { return (r & 3) + 8 * (r >> 2) + 4 * hi; }
__device__ __forceinline__ u32x4 pack8f(const float* v) { u32x4 w; w.x = cvt_pk_bf16_c(v[0], v[1]); w.y = cvt_pk_bf16_c(v[2], v[3]); w.z = cvt_pk_bf16_c(v[4], v[5]); w.w = cvt_pk_bf16_c(v[6], v[7]); return w; }
__device__ __forceinline__ bf16x8 as_frag(u32x4 w) { return *reinterpret_cast<bf16x8*>(&w); }
__device__ __forceinline__ f32x4 prod16(const LAS float* Aptr, int pitch, f32x4 M, f32x4 R, int lane) {
    const f32x4 a4 = *(const LAS f32x4*)(Aptr + (lane & 15) * pitch + 4 * (lane >> 4));
    R = __builtin_amdgcn_mfma_f32_16x16x4f32(a4[0], M[0], R, 0, 0, 0); R = __builtin_amdgcn_mfma_f32_16x16x4f32(a4[1], M[1], R, 0, 0, 0);
    R = __builtin_amdgcn_mfma_f32_16x16x4f32(a4[2], M[2], R, 0, 0, 0); R = __builtin_amdgcn_mfma_f32_16x16x4f32(a4[3], M[3], R, 0, 0, 0); return R;
}
template <int B> __device__ __forceinline__ void inv_col(LAS unsigned char* lds, int lane) {
    const LAS float* Lm = (const LAS float*)(lds + O_LM); const LAS float* Dm = (const LAS float*)(lds + O_DM); const LAS float* SC = (const LAS float*)(lds + O_SC);
    const int j = lane & 15, q = lane >> 4, jj = 16 * B + j;
    f32x4 Tb[4];
#pragma unroll
    for (int a = 0; a < 4; ++a) Tb[a] = (f32x4){0.f, 0.f, 0.f, 0.f};
#pragma unroll
    for (int s = 0; s < 4; ++s) Tb[B][s] = Dm[(B * 16 + 4 * q + s) * 16 + j];
#pragma unroll
    for (int a = B + 1; a < 4; ++a) { f32x4 Y = (f32x4){0.f, 0.f, 0.f, 0.f};
#pragma unroll
        for (int c = B; c < a; ++c) Y = prod16(Lm + (16 * a) * 68 + 16 * c, 68, Tb[c], Y, lane);
        const f32x4 R = prod16(Dm + a * 256, 16, Y, (f32x4){0.f, 0.f, 0.f, 0.f}, lane); Tb[a] = -R; }
    const float bt = SC[64 + jj], bg = bt * SC[128 + jj];
#pragma unroll
    for (int a = 0; a < 4; ++a)
#pragma unroll
        for (int s = 0; s < 4; ++s) { const int i = 16 * a + 4 * q + s; const float t = Tb[a][s];
            *(LAS unsigned short*)(lds + O_TK + i * PT + jj * 2) = (unsigned short)(cvt_pk_bf16_c(-bg * t, 0.f) & 0xffffu);
            *(LAS unsigned short*)(lds + O_TV + i * PT + jj * 2) = (unsigned short)(cvt_pk_bf16_c(bt * t, 0.f) & 0xffffu); }
}
}

__device__ __forceinline__ void phase_dn1(LAS unsigned char* lds, const bf16_t* __restrict__ proj, const float* __restrict__ convw, const float* __restrict__ gl, const float* __restrict__ betal, unsigned char* dnout) {
    using namespace dn;
    const int tid = otid(), lane = tid & 63, wid = __builtin_amdgcn_readfirstlane(tid >> 6), r = lane & 31, hi = lane >> 5;
    LAS float* SC = (LAS float*)(lds + O_SC);
    LAS float* Lm = (LAS float*)(lds + O_LM);
    LAS float* Dm = (LAS float*)(lds + O_DM);
    const int g = tid & 31, run = tid >> 5; const bool isq = g < 16;
    const int gv = tid & 15, tv = tid >> 4;
    auto unpack8 = [](const u32x4& w, float (&f)[8]) { f[0] = bflo(w.x); f[1] = bfhi(w.x); f[2] = bflo(w.y); f[3] = bfhi(w.y); f[4] = bflo(w.z); f[5] = bfhi(w.z); f[6] = bflo(w.w); f[7] = bfhi(w.w); };
    for (int ck = blockIdx.x; ck < NB * NH * (SEQ / 64); ck += gridDim.x) {
        const int bh = ck >> 5, n = ck & 31, b = bh >> 3, h = bh & 7, t0 = n * 64; const size_t tok0 = (size_t)b * SEQ;
        unsigned char* co = dnout + (size_t)ck * CHUNK_BYTES;
        const int chqk = (isq ? 0 : 1024) + h * 128 + 8 * (g & 15), chv = 2048 + h * 128 + 8 * gv;
        {
            u32x4 rq[7];
#pragma unroll
            for (int i = 0; i < 7; ++i) { const int s = t0 + 4 * run - 3 + i; rq[i] = (s >= 0) ? *(const u32x4*)(proj + (tok0 + s) * 4096 + chqk) : (u32x4){0u, 0u, 0u, 0u}; }
            u32x4 rv[5];
#pragma unroll
            for (int i = 0; i < 5; ++i) { const int s = t0 + 2 * tv - 3 + i; rv[i] = (s >= 0) ? *(const u32x4*)(proj + (tok0 + s) * 4096 + chv) : (u32x4){0u, 0u, 0u, 0u}; }
            float wq[4][8], wv[4][8];
#pragma unroll
            for (int j = 0; j < 4; ++j)
#pragma unroll
                for (int e = 0; e < 8; ++e) { wq[j][e] = convw[j * 3072 + chqk + e]; wv[j][e] = convw[j * 3072 + chv + e]; }
            float xr[7][8];
#pragma unroll
            for (int i = 0; i < 7; ++i) unpack8(rq[i], xr[i]);
            float val[4][8];
#pragma unroll
            for (int u = 0; u < 4; ++u) { float ss = 0.f;
#pragma unroll
                for (int e = 0; e < 8; ++e) { float a = wq[0][e] * xr[u][e]; a = fmaf(wq[1][e], xr[u + 1][e], a); a = fmaf(wq[2][e], xr[u + 2][e], a); a = fmaf(wq[3][e], xr[u + 3][e], a);
                    val[u][e] = a * __builtin_amdgcn_rcpf(1.f + __expf(-a)); ss = fmaf(val[u][e], val[u][e], ss); }
                ss = red16(ss);
                const float sc = rsqrtf(ss + 1e-6f) * (isq ? 0.08838834764831845f : 1.f);
#pragma unroll
                for (int e = 0; e < 8; ++e) val[u][e] *= sc;
                *(LAS u32x4*)(lds + (isq ? O_QR : O_KR) + (4 * run + u) * PK + (g & 15) * 16) = pack8f(val[u]); }
            if (!isq) {
#pragma unroll
                for (int e = 0; e < 8; ++e) { u32x2 w; w.x = cvt_pk_bf16_c(val[0][e], val[1][e]); w.y = cvt_pk_bf16_c(val[2][e], val[3][e]); *(LAS u32x2*)(lds + O_KT + (8 * (g & 15) + e) * PT + (4 * run) * 2) = w; } }
            float xv[5][8];
#pragma unroll
            for (int i = 0; i < 5; ++i) unpack8(rv[i], xv[i]);
#pragma unroll
            for (int e = 0; e < 8; ++e) { float y2[2];
#pragma unroll
                for (int u = 0; u < 2; ++u) { float a = wv[0][e] * xv[u][e]; a = fmaf(wv[1][e], xv[u + 1][e], a); a = fmaf(wv[2][e], xv[u + 2][e], a); a = fmaf(wv[3][e], xv[u + 3][e], a); y2[u] = a * __builtin_amdgcn_rcpf(1.f + __expf(-a)); }
                *(LAS unsigned*)(lds + O_VT + (8 * gv + e) * PT + (2 * tv) * 2) = cvt_pk_bf16_c(y2[0], y2[1]); }
            if (wid == 0) {
                const size_t ix = (tok0 + t0 + lane) * 8 + h; float v = gl[ix];
#pragma unroll
                for (int off = 1; off < 64; off <<= 1) { const float u = __shfl_up(v, off); v += (lane >= off) ? u : 0.f; }
                const float glast = __shfl(v, 63);
                SC[lane] = v; SC[64 + lane] = betal[ix]; SC[128 + lane] = __expf(v); SC[192 + lane] = __expf(glast - v);
                if (lane == 0) *(float*)(co + C_EG) = __expf(glast);
            }
        }
        __syncthreads();
        {
            const int mat = wid >> 2, ta = (wid >> 1) & 1, tb = wid & 1;
            const bool act = mat == 0 ? (ta >= tb) : (ta <= tb);
            if (act) {
                f32x16 acc = {};
                const LAS unsigned char* Ap = lds + O_KR + (32 * ta + r) * PK + hi * 16;
                const LAS unsigned char* Bp = lds + (mat == 0 ? O_KR : O_QR) + (32 * tb + r) * PK + hi * 16;
#pragma unroll
                for (int s = 0; s < 8; ++s) acc = __builtin_amdgcn_mfma_f32_32x32x16_bf16(*(const LAS bf16x8*)(Ap + s * 32), *(const LAS bf16x8*)(Bp + s * 32), acc, 0, 0, 0);
                const int cidx = 32 * tb + r;
                const float gcc = SC[cidx];
                if (mat == 0) {
#pragma unroll
                    for (int rg = 0; rg < 16; ++rg) { const int i = 32 * ta + crow(rg, hi); const float e = __expf(fminf(SC[i] - gcc, 0.f));
                        Lm[i * 68 + cidx] = (i > cidx) ? SC[64 + i] * acc[rg] * e : 0.f; }
                } else {
                    float pv[16];
#pragma unroll
                    for (int rg = 0; rg < 16; ++rg) { const int j = 32 * ta + crow(rg, hi); const float e = __expf(fminf(gcc - SC[j], 0.f)); pv[rg] = (cidx >= j) ? acc[rg] * e : 0.f; }
                    unsigned char* dst = co + C_P + ((tb + ta) * 2) * 1024 + lane * 16;
                    *(u32x4*)dst = pack8f(pv); *(u32x4*)(dst + 1024) = pack8f(pv + 8);
                }
            }
        }
        __syncthreads();
        if (wid == 0) {
            const int c = lane & 15, a = lane >> 4; float x[16];
#pragma unroll
            for (int i = 0; i < 16; ++i) { float acc = (i == c) ? 1.f : 0.f;
#pragma unroll
                for (int j = 0; j < i; ++j) acc = fmaf(-Lm[(16 * a + i) * 68 + 16 * a + j], x[j], acc);
                x[i] = acc; Dm[(a * 16 + i) * 16 + c] = acc; }
        }
        __syncthreads();
        if (wid == 0) inv_col<0>(lds, lane); else if (wid == 1) inv_col<1>(lds, lane); else if (wid == 2) inv_col<2>(lds, lane); else if (wid == 3) inv_col<3>(lds, lane);
        __syncthreads();
#pragma unroll
        for (int pass = 0; pass < 2; ++pass) {
            const int tile = wid + 8 * pass;
            f32x16 acc = {};
            if (tile < 8) { const int dt = tile >> 1, it = tile & 1;
                const LAS unsigned char* Ap = lds + O_KT + (32 * dt + r) * PT + hi * 16; const LAS unsigned char* Bp = lds + O_TK + (32 * it + r) * PT + hi * 16;
                acc = __builtin_amdgcn_mfma_f32_32x32x16_bf16(*(const LAS bf16x8*)(Ap), *(const LAS bf16x8*)(Bp), acc, 0, 0, 0);
                acc = __builtin_amdgcn_mfma_f32_32x32x16_bf16(*(const LAS bf16x8*)(Ap + 32), *(const LAS bf16x8*)(Bp + 32), acc, 0, 0, 0);
                if (it == 1) { acc = __builtin_amdgcn_mfma_f32_32x32x16_bf16(*(const LAS bf16x8*)(Ap + 64), *(const LAS bf16x8*)(Bp + 64), acc, 0, 0, 0);
                               acc = __builtin_amdgcn_mfma_f32_32x32x16_bf16(*(const LAS bf16x8*)(Ap + 96), *(const LAS bf16x8*)(Bp + 96), acc, 0, 0, 0); }
                float pv[16];
#pragma unroll
                for (int rg = 0; rg < 16; ++rg) pv[rg] = acc[rg];
                unsigned char* dst = co + C_WN + ((it * 4 + dt) * 2) * 1024 + lane * 16;
                *(u32x4*)dst = pack8f(pv); *(u32x4*)(dst + 1024) = pack8f(pv + 8);
            } else { const int it = (tile - 8) >> 2, et = (tile - 8) & 3;
                const LAS unsigned char* Ap = lds + O_TV + (32 * it + r) * PT + hi * 16; const LAS unsigned char* Bp = lds + O_VT + (32 * et + r) * PT + hi * 16;
                acc = __builtin_amdgcn_mfma_f32_32x32x16_bf16(*(const LAS bf16x8*)(Ap), *(const LAS bf16x8*)(Bp), acc, 0, 0, 0);
                acc = __builtin_amdgcn_mfma_f32_32x32x16_bf16(*(const LAS bf16x8*)(Ap + 32), *(const LAS bf16x8*)(Bp + 32), acc, 0, 0, 0);
                if (it == 1) { acc = __builtin_amdgcn_mfma_f32_32x32x16_bf16(*(const LAS bf16x8*)(Ap + 64), *(const LAS bf16x8*)(Bp + 64), acc, 0, 0, 0);
                               acc = __builtin_amdgcn_mfma_f32_32x32x16_bf16(*(const LAS bf16x8*)(Ap + 96), *(const LAS bf16x8*)(Bp + 96), acc, 0, 0, 0); }
                float pv[16];
#pragma unroll
                for (int rg = 0; rg < 16; ++rg) pv[rg] = acc[rg];
                unsigned char* dst = co + C_U + (it * 4 + et) * 2048 + lane * 32;
                *(u32x4*)dst = pack8f(pv); *(u32x4*)(dst + 16) = pack8f(pv + 8);
            }
        }
#pragma unroll
        for (int pass = 0; pass < 2; ++pass) {
            const int f = 2 * wid + pass, s = f & 1;
            {
                const int it = f >> 3, dt = (f >> 1) & 3; const int i = 32 * it + r, d0 = 32 * dt + 16 * s + 4 * hi; const float gm = SC[128 + i];
                const u32x2 a = *(const LAS u32x2*)(lds + O_QR + i * PK + d0 * 2), c = *(const LAS u32x2*)(lds + O_QR + i * PK + (d0 + 8) * 2);
                float pv[8] = {bflo(a.x) * gm, bfhi(a.x) * gm, bflo(a.y) * gm, bfhi(a.y) * gm, bflo(c.x) * gm, bfhi(c.x) * gm, bflo(c.y) * gm, bfhi(c.y) * gm};
                *(u32x4*)(co + C_QD + f * 1024 + lane * 16) = pack8f(pv);
            }
            {
                const int dt = f >> 2, jt = (f >> 1) & 1; const int d = 32 * dt + r, j0 = 32 * jt + 16 * s + 4 * hi;
                const u32x2 a = *(const LAS u32x2*)(lds + O_KT + d * PT + j0 * 2), c = *(const LAS u32x2*)(lds + O_KT + d * PT + (j0 + 8) * 2);
                const f32x4 d0 = *(const LAS f32x4*)(SC + 192 + j0), d1 = *(const LAS f32x4*)(SC + 192 + j0 + 8);
                float pv[8] = {bflo(a.x) * d0[0], bfhi(a.x) * d0[1], bflo(a.y) * d0[2], bfhi(a.y) * d0[3], bflo(c.x) * d1[0], bfhi(c.x) * d1[1], bflo(c.y) * d1[2], bfhi(c.y) * d1[3]};
                *(u32x4*)(co + C_KD + f * 1024 + lane * 16) = pack8f(pv);
            }
        }
        __syncthreads();
    }
}

__device__ __forceinline__ void phase_dn2(LAS unsigned char* lds, const unsigned char* dnout, float* og) {
    using namespace dn;
    const int tid = otid(), lane = tid & 63, wid = __builtin_amdgcn_readfirstlane(tid >> 6), r = lane & 31, hi = lane >> 5;
    if (wid != 0) return;
    constexpr int BUF = 59392;
    for (int L = blockIdx.x; L < 256; L += gridDim.x) {
        const int bh = (L & 7) + 8 * (L >> 5), s4 = (L >> 3) & 3, b = bh >> 3, h = bh & 7; const size_t tok0 = (size_t)b * SEQ;
        const unsigned char* cb = dnout + (size_t)bh * 32 * CHUNK_BYTES;
        auto issue = [&](int n, int buf) { const unsigned char* src = cb + (size_t)n * CHUNK_BYTES + lane * 16;
#pragma unroll 6
            for (int f = 0; f < 54; ++f) __builtin_amdgcn_global_load_lds((const unsigned*)(src + f * 1024), (LAS unsigned*)(lds + buf * BUF + f * 1024), 16, 0, 0);
#pragma unroll
            for (int it = 0; it < 2; ++it)
#pragma unroll
                for (int pc = 0; pc < 2; ++pc) __builtin_amdgcn_global_load_lds((const unsigned*)(src + C_U + (it * 4 + s4) * 2048 + pc * 1024), (LAS unsigned*)(lds + buf * BUF + 55296 + it * 2048 + pc * 1024), 16, 0, 0);
        };
        f32x16 S[4];
#pragma unroll
        for (int dt = 0; dt < 4; ++dt) S[dt] = (f32x16){};
#if !defined(DN2_SYNC) && !defined(DN2_NODMA)
        issue(0, 0);
#endif
        float eg = ld_agent_f32((const float*)(cb + C_EG));
        for (int n = 0; n < 32; ++n) {
            const int buf = n & 1;
#if defined(DN2_SYNC) && !defined(DN2_NODMA)
            issue(n, buf);
#endif
            asm volatile("s_waitcnt vmcnt(0)" ::: "memory");
            float egn = eg;
#if defined(DN2_SYNC) || defined(DN2_NODMA)
            if (n + 1 < 32) egn = ld_agent_f32((const float*)(cb + (size_t)(n + 1) * CHUNK_BYTES + C_EG));
#else
            if (n + 1 < 32) { egn = ld_agent_f32((const float*)(cb + (size_t)(n + 1) * CHUNK_BYTES + C_EG)); issue(n + 1, buf ^ 1); }
#endif
#ifdef DN2_NODMA
            const unsigned char* bp = cb + (size_t)n * CHUNK_BYTES + lane * 16;
#define DN2_FR(p) (*(const bf16x8*)(p))
#else
            const LAS unsigned char* bp = lds + buf * BUF + lane * 16;
#define DN2_FR(p) (*(const LAS bf16x8*)(p))
#endif
            bf16x8 Sb[4][2];
#pragma unroll
            for (int dt = 0; dt < 4; ++dt)
#pragma unroll
                for (int s = 0; s < 2; ++s) { float t8[8];
#pragma unroll
                    for (int j = 0; j < 8; ++j) t8[j] = S[dt][8 * s + j];
                    Sb[dt][s] = as_frag(pack8f(t8)); }
            f32x16 Vn[2], O[2];
#pragma unroll
            for (int it = 0; it < 2; ++it) {
#ifdef DN2_NODMA
                const unsigned char* up = cb + (size_t)n * CHUNK_BYTES + C_U + (it * 4 + s4) * 2048 + lane * 32; const u32x4 a = *(const u32x4*)up, c = *(const u32x4*)(up + 16);
#else
                const LAS unsigned char* up = lds + buf * BUF + 55296 + it * 2048 + lane * 32; const u32x4 a = *(const LAS u32x4*)up, c = *(const LAS u32x4*)(up + 16);
#endif

                Vn[it][0] = bflo(a.x); Vn[it][1] = bfhi(a.x); Vn[it][2] = bflo(a.y); Vn[it][3] = bfhi(a.y); Vn[it][4] = bflo(a.z); Vn[it][5] = bfhi(a.z); Vn[it][6] = bflo(a.w); Vn[it][7] = bfhi(a.w);
                Vn[it][8] = bflo(c.x); Vn[it][9] = bfhi(c.x); Vn[it][10] = bflo(c.y); Vn[it][11] = bfhi(c.y); Vn[it][12] = bflo(c.z); Vn[it][13] = bfhi(c.z); Vn[it][14] = bflo(c.w); Vn[it][15] = bfhi(c.w);
                O[it] = (f32x16){}; }
#pragma unroll
            for (int it = 0; it < 2; ++it)
#pragma unroll
                for (int dt = 0; dt < 4; ++dt)
#pragma unroll
                    for (int s = 0; s < 2; ++s) { const int f = (it * 4 + dt) * 2 + s;
                        Vn[it] = __builtin_amdgcn_mfma_f32_32x32x16_bf16(DN2_FR(bp + C_WN + f * 1024), Sb[dt][s], Vn[it], 0, 0, 0);
                        O[it] = __builtin_amdgcn_mfma_f32_32x32x16_bf16(DN2_FR(bp + C_QD + f * 1024), Sb[dt][s], O[it], 0, 0, 0); }
            bf16x8 Vb[2][2];
#pragma unroll
            for (int jt = 0; jt < 2; ++jt)
#pragma unroll
                for (int s = 0; s < 2; ++s) { float t8[8];
#pragma unroll
                    for (int j = 0; j < 8; ++j) t8[j] = Vn[jt][8 * s + j];
                    Vb[jt][s] = as_frag(pack8f(t8)); }
#pragma unroll
            for (int s = 0; s < 2; ++s) {
                O[0] = __builtin_amdgcn_mfma_f32_32x32x16_bf16(DN2_FR(bp + C_P + (0 * 2 + s) * 1024), Vb[0][s], O[0], 0, 0, 0);
                O[1] = __builtin_amdgcn_mfma_f32_32x32x16_bf16(DN2_FR(bp + C_P + (1 * 2 + s) * 1024), Vb[0][s], O[1], 0, 0, 0);
                O[1] = __builtin_amdgcn_mfma_f32_32x32x16_bf16(DN2_FR(bp + C_P + (2 * 2 + s) * 1024), Vb[1][s], O[1], 0, 0, 0); }
#pragma unroll
            for (int dt = 0; dt < 4; ++dt) { S[dt] = S[dt] * eg;
#pragma unroll
                for (int jt = 0; jt < 2; ++jt)
#pragma unroll
                    for (int s = 0; s < 2; ++s) S[dt] = __builtin_amdgcn_mfma_f32_32x32x16_bf16(DN2_FR(bp + C_KD + ((dt * 2 + jt) * 2 + s) * 1024), Vb[jt][s], S[dt], 0, 0, 0); }
            asm volatile("s_waitcnt vmcnt(0)" ::: "memory");
            float* ob = og + (tok0 + (size_t)n * 64) * DM + h * 128 + s4 * 32 + r;
#pragma unroll
            for (int it = 0; it < 2; ++it)
#pragma unroll
                for (int rg = 0; rg < 16; ++rg) ob[(size_t)(32 * it + crow(rg, hi)) * DM] = O[it][rg];
            eg = egn;
        }
        asm volatile("s_waitcnt vmcnt(0)" ::: "memory");
    }
}
#define XB_TMO      128
#define XB_XCNT(j)  (256  + 64 * (j))
#define XB_XSUB(j)  (1280 + 64 * (j))
#define XB_XGEN(j)  (2304 + 64 * (j))
#define XB_TOP      3328
#define XB_TOPGEN   3392
#define XCD_BAR_WORDS 3456
#define XB_SPIN_CAP (1u << 18)

__device__ __forceinline__ unsigned xb_ld(unsigned* p)              { return __hip_atomic_load(p, __ATOMIC_RELAXED, __HIP_MEMORY_SCOPE_AGENT); }
__device__ __forceinline__ unsigned xb_add(unsigned* p, unsigned v) { return __hip_atomic_fetch_add(p, v, __ATOMIC_RELAXED, __HIP_MEMORY_SCOPE_AGENT); }
__device__ __forceinline__ unsigned xb_xcc_id() { return (unsigned)__builtin_amdgcn_s_getreg((3 << 11) | 20) & 0xFu; }
#define XB_SPIN(cond, bar) do { unsigned _sp = 0; while (cond) { __builtin_amdgcn_s_sleep(1); \
    if ((++_sp & 255u) == 0u) { if (xb_ld(&(bar)[XB_TMO])) break; if (_sp > XB_SPIN_CAP) { atomicAdd(&(bar)[XB_TMO], 1u); break; } } } } while (0)

struct XcdBarrier {
    unsigned* bar; unsigned x;
    volatile LAS unsigned* st;
};

__device__ __forceinline__ XcdBarrier xcd_barrier_post(unsigned* bar, volatile LAS unsigned* st) {
    XcdBarrier b; b.bar = bar; b.x = xb_xcc_id(); b.st = st;
    if (threadIdx.x == 0) (void)xb_add(&bar[XB_XCNT(b.x)], 1u);
    return b;
}
__device__ __forceinline__ void xcd_barrier_complete(unsigned* bar, unsigned x, unsigned& nloc, unsigned& nx) {
    const unsigned G = gridDim.x * gridDim.y * gridDim.z;
    unsigned sum, cnt, mine, sp = 0u;
    for (;;) {
        sum = 0u; cnt = 0u; mine = 0u;
#pragma unroll
        for (unsigned j = 0; j < 16; ++j) { const unsigned c = xb_ld(&bar[XB_XCNT(j)]); sum += c; cnt += (c > 0u) ? 1u : 0u; mine = (j == x) ? c : mine; }
        if (sum == G) break;
        __builtin_amdgcn_s_sleep(1);
        if ((++sp & 255u) == 0u) { if (xb_ld(&bar[XB_TMO])) break; if (sp > XB_SPIN_CAP) { atomicAdd(&bar[XB_TMO], 1u); break; } }
    }
    nloc = mine > 0u ? mine : 1u; nx = cnt > 0u ? cnt : 1u;
}

__device__ __forceinline__ void xcd_barrier(const XcdBarrier& b) {
    asm volatile("s_waitcnt vmcnt(0)" ::: "memory");
    __syncthreads();
    if (threadIdx.x == 0) {
        unsigned* bar = b.bar;
        __builtin_amdgcn_s_waitcnt(0);
        unsigned nloc = b.st[0], nx = b.st[1];
        if (nloc == 0u) { xcd_barrier_complete(bar, b.x, nloc, nx); b.st[0] = nloc; b.st[1] = nx; }
        const unsigned old = xb_add(&bar[XB_XSUB(b.x)], 1u);
        const unsigned gen = old / nloc;
        if (old + 1u == (gen + 1u) * nloc) {
            __builtin_amdgcn_fence(__ATOMIC_RELEASE, "agent");
            asm volatile("s_waitcnt vmcnt(0)" ::: "memory");
            const unsigned og = xb_add(&bar[XB_TOP], 1u);
            const unsigned tg = og / nx;
            if (og + 1u == (tg + 1u) * nx) xb_add(&bar[XB_TOPGEN], 1u);
            else XB_SPIN(xb_ld(&bar[XB_TOPGEN]) == tg, bar);
            __builtin_amdgcn_fence(__ATOMIC_ACQUIRE, "agent");
            xb_add(&bar[XB_XGEN(b.x)], 1u);
            asm volatile("s_waitcnt vmcnt(0)" ::: "memory");
        } else {
            XB_SPIN(xb_ld(&bar[XB_XGEN(b.x)]) == gen, bar);
            __builtin_amdgcn_fence(__ATOMIC_ACQUIRE, "agent");
            asm volatile("s_waitcnt vmcnt(0)" ::: "memory");
        }
    }
    __syncthreads();
}
struct Params {
    const float *x, *a_w_in, *a_conv_w, *a_log, *a_dt, *a_norm_w, *a_w_out, *b_w_kv, *b_w_q, *b_w_o, *ffn_w1, *ffn_w3, *ffn_w2, *moe_router, *moe_w1, *moe_w3, *moe_w2, *ln_g, *ln_b;
    float* out;
    bf16_t *Wt_in, *Wt_out, *Wt_13, *Wt_2, *Wt_kvq, *Wt_o, *Wt_m13, *Wt_m2;
    bf16_t *xb, *proj, *ogb, *x1b, *hidb, *x2b, *Kb, *Vb, *Qb, *attb, *x3b;
    float *g, *beta, *cs, *sn, *ypre, *x1, *x2, *kmp, *x3, *tg, *gate_of_slot, *of;
    bf16_t *hidm, *ysb;
    float* ysp;
    int *te, *pos_of, *gcnt, *tok_of_slot, *slot_of;
    unsigned* bar; unsigned char* dnout;
    int cvt_split, cvt_split0;
    CvtTable cvt;
};

enum { PH_PROLOGUE = 0, PH_PROJ, PH_DN, PH_DN1, PH_DN2, PH_CVT_REST, PH_DNPOST, PH_WOUT, PH_LN1, PH_FFN_UP, PH_FFN_DN, PH_LN2, PH_KVQ, PH_ATTN, PH_WO, PH_LN3, PH_LN3R, PH_CVT_MOE, PH_MAP, PH_MUP_A, PH_MDN_A, PH_MUP_B, PH_MDN_B, PH_FINAL };
template <int PH> __device__ __forceinline__ void run_phase(const Params& p, LAS unsigned char* lds) {
    if constexpr (PH == PH_PROLOGUE) {
        phase_x_prep(lds, p.x, p.a_w_in, p.a_log, p.a_dt, p.xb, p.g, p.beta);
        phase_rope_table(p.cs, p.sn);
        if (blockIdx.x == 0 && threadIdx.x < 8) p.gcnt[threadIdx.x] = 0;
        phase_cvt_weights(lds, p.cvt, 0, p.cvt_split0);
    } else if constexpr (PH == PH_PROJ) {
        pg8::DenseSched S; S.init(p.xb, p.Wt_in, NT, 4096, DM);
        pg8::EpiBf16 E{p.proj, 4096, 0};
        pg8::gemm_phase<pg8::EpiBf16, pg8::DenseSched, false>(lds, DM, S, E, nullptr);
    } else if constexpr (PH == PH_DN) {
        phase_dn(lds, p.proj, p.a_conv_w, p.g, p.beta, p.of);
    } else if constexpr (PH == PH_DN1) {
        phase_dn1(lds, p.proj, p.a_conv_w, p.g, p.beta, p.dnout);
    } else if constexpr (PH == PH_DN2) {
        phase_dn2(lds, p.dnout, p.of);
    } else if constexpr (PH == PH_CVT_REST) {
        phase_cvt_weights(lds, p.cvt, p.cvt_split0, p.cvt.ntiles);
    } else if constexpr (PH == PH_DNPOST) {
        phase_dn_post(p.of, p.proj, p.a_norm_w, p.ogb);
    } else if constexpr (PH == PH_WOUT) {
        pg8::DenseSched S; S.init(p.ogb, p.Wt_out, NT, DM, DM);
        pg8::EpiResF32 E{p.ypre, p.x, DM, 0};
        pg8::gemm_phase<pg8::EpiResF32, pg8::DenseSched, false>(lds, DM, S, E, nullptr);
    } else if constexpr (PH == PH_LN1) {
        phase_ln(p.ypre, p.ln_g + 0 * DM, p.ln_b + 0 * DM, p.x1, p.x1b);
    } else if constexpr (PH == PH_FFN_UP) {
        pg8::DenseSched S; S.init(p.x1b, p.Wt_13, NT, 2 * FF, DM);
        pg8::EpiSwiGLU E{p.hidb, FF, 0};
        pg8::gemm_phase<pg8::EpiSwiGLU, pg8::DenseSched, false>(lds, DM, S, E, nullptr);
    } else if constexpr (PH == PH_FFN_DN) {
        pg8::DenseSched S; S.init(p.hidb, p.Wt_2, NT, DM, FF);
        pg8::EpiResF32 E{p.ypre, p.x1, DM, 0};
        pg8::gemm_phase<pg8::EpiResF32, pg8::DenseSched, false>(lds, FF, S, E, nullptr);
    } else if constexpr (PH == PH_LN2) {
        phase_ln(p.ypre, p.ln_g + 1 * DM, p.ln_b + 1 * DM, p.x2, p.x2b);
    } else if constexpr (PH == PH_KVQ) {
        pg8::DenseSched S; S.init(p.x2b, p.Wt_kvq, NT, 3072, DM);
        pg8::EpiKVQ E{p.Kb, p.Vb, p.Qb, p.kmp, p.cs, p.sn};
        pg8::gemm_phase<pg8::EpiKVQ, pg8::DenseSched, false>(lds, DM, S, E, nullptr);
    } else if constexpr (PH == PH_ATTN) {
        phase_attn(lds, p.Qb, p.Kb, p.Vb, p.kmp, p.attb);
    } else if constexpr (PH == PH_WO) {
        pg8::DenseSched S; S.init(p.attb, p.Wt_o, NT, DM, DM);
        pg8::EpiResF32 E{p.ypre, p.x2, DM, 0};
        pg8::gemm_phase<pg8::EpiResF32, pg8::DenseSched, false>(lds, DM, S, E, nullptr);
    } else if constexpr (PH == PH_LN3) {
        phase_ln(p.ypre, p.ln_g + 2 * DM, p.ln_b + 2 * DM, p.x3, p.x3b);
    } else if constexpr (PH == PH_LN3R) {
        phase_ln_router(lds, p.ypre, p.ln_g + 2 * DM, p.ln_b + 2 * DM, p.moe_router, p.x3, p.x3b, p.te, p.tg, p.pos_of, p.gcnt, p.tok_of_slot);
    } else if constexpr (PH == PH_CVT_MOE) {
        phase_cvt_weights(lds, p.cvt, p.cvt_split, p.cvt.ntiles);
    } else if constexpr (PH == PH_MAP) {
        phase_moe_map(p.gcnt, p.te, p.tg, p.pos_of, p.tok_of_slot, p.gate_of_slot, p.slot_of);
    } else if constexpr (PH == PH_MUP_A || PH == PH_MUP_B || PH == PH_MDN_A || PH == PH_MDN_B) {
        constexpr bool UP = (PH == PH_MUP_A || PH == PH_MUP_B), HB = (PH == PH_MUP_B || PH == PH_MDN_B);
        pg8::MoeSched S; moe_offsets(p.gcnt, S.off);
        const int nrt = S.off[8] >> 8;
        S.rt0 = HB ? 64 : 0; S.G = (int)gridDim.x; S.c = (int)blockIdx.x; S.nmini = 0;
        if constexpr (UP) {
            S.rt1 = HB ? nrt : 64;
            S.A = (const char*)p.x3b; S.Bt = (const char*)p.Wt_m13; S.nN = 2 * FF / 256; S.gather = 1; S.ntk = DM / 64; S.tstepA = 0; S.tstepB = (size_t)256 * DM * 2; S.estride = (size_t)2 * FF * DM * 2;
            pg8::EpiSwiGLU E{p.hidm, FF, S.rt0 * 256};
            pg8::gemm_phase<pg8::EpiSwiGLU, pg8::MoeSched, true>(lds, DM, S, E, p.tok_of_slot);
        } else {
            S.rt1 = HB ? 128 : 64; if (HB) S.nmini = (nrt - 128) * 28;
            S.A = (const char*)p.hidm; S.Bt = (const char*)p.Wt_m2; S.nN = DM / 256; S.gather = 0; S.ntk = FF / 64; S.tstepA = (size_t)256 * FF * 2; S.tstepB = (size_t)256 * FF * 2; S.estride = (size_t)DM * FF * 2;
            pg8::EpiMoeDown E{p.ysb, p.gate_of_slot, p.ysp};
            pg8::gemm_phase<pg8::EpiMoeDown, pg8::MoeSched, false>(lds, FF, S, E, nullptr);
        }
    } else if constexpr (PH == PH_FINAL) {
        phase_final(p.x3, p.ysb, p.ysp, p.gate_of_slot, p.slot_of, p.ln_g + 3 * DM, p.ln_b + 3 * DM, p.out);
    }
}
template <int PH> __global__ __launch_bounds__(512, 2) void k_ph(Params p) {
    extern __shared__ __attribute__((aligned(16))) unsigned char shm[];
    run_phase<PH>(p, (LAS unsigned char*)shm);
}
constexpr int LDS_BYTES = 147456 + 256;
__global__ __launch_bounds__(512, 2) void k_mega(Params p) {
    extern __shared__ __attribute__((aligned(16))) unsigned char shm[];
    LAS unsigned char* lds = (LAS unsigned char*)shm;
    volatile LAS unsigned* xbw = (volatile LAS unsigned*)(lds + 147456);
    if (threadIdx.x == 0) { xbw[0] = 0u; xbw[1] = 0u; xbw[2] = 0u; xbw[3] = 0u; }
    __syncthreads();
    XcdBarrier bar = xcd_barrier_post(p.bar, xbw);
    run_phase<PH_PROLOGUE>(p, lds); xcd_barrier(bar);
#if defined(DUP_PH_PROLOGUE)
    run_phase<PH_PROLOGUE>(p, lds); xcd_barrier(bar);
#endif
    run_phase<PH_PROJ>(p, lds); xcd_barrier(bar);
#if defined(DUP_PH_PROJ)
    run_phase<PH_PROJ>(p, lds); xcd_barrier(bar);
#endif
    run_phase<PH_DN1>(p, lds);      xcd_barrier(bar);
#if defined(DUP_PH_DN1)
    run_phase<PH_DN1>(p, lds); xcd_barrier(bar);
#endif
    run_phase<PH_DN2>(p, lds);      xcd_barrier(bar);
#if defined(DUP_PH_DN2)
    run_phase<PH_DN2>(p, lds); xcd_barrier(bar);
#endif
    run_phase<PH_CVT_REST>(p, lds); xcd_barrier(bar);
#if defined(DUP_PH_CVT_REST)
    run_phase<PH_CVT_REST>(p, lds); xcd_barrier(bar);
#endif
    run_phase<PH_DNPOST>(p, lds); xcd_barrier(bar);
#if defined(DUP_PH_DNPOST)
    run_phase<PH_DNPOST>(p, lds); xcd_barrier(bar);
#endif
    run_phase<PH_WOUT>(p, lds); xcd_barrier(bar);
#if defined(DUP_PH_WOUT)
    run_phase<PH_WOUT>(p, lds); xcd_barrier(bar);
#endif
    run_phase<PH_LN1>(p, lds); xcd_barrier(bar);
#if defined(DUP_PH_LN1)
    run_phase<PH_LN1>(p, lds); xcd_barrier(bar);
#endif
    run_phase<PH_FFN_UP>(p, lds); xcd_barrier(bar);
#if defined(DUP_PH_FFN_UP)
    run_phase<PH_FFN_UP>(p, lds); xcd_barrier(bar);
#endif
    run_phase<PH_FFN_DN>(p, lds); xcd_barrier(bar);
#if defined(DUP_PH_FFN_DN)
    run_phase<PH_FFN_DN>(p, lds); xcd_barrier(bar);
#endif
    run_phase<PH_LN2>(p, lds); xcd_barrier(bar);
#if defined(DUP_PH_LN2)
    run_phase<PH_LN2>(p, lds); xcd_barrier(bar);
#endif
    run_phase<PH_KVQ>(p, lds); xcd_barrier(bar);
#if defined(DUP_PH_KVQ)
    run_phase<PH_KVQ>(p, lds); xcd_barrier(bar);
#endif
    run_phase<PH_ATTN>(p, lds); xcd_barrier(bar);
#if defined(DUP_PH_ATTN)
    run_phase<PH_ATTN>(p, lds); xcd_barrier(bar);
#endif
    run_phase<PH_WO>(p, lds); xcd_barrier(bar);
#if defined(DUP_PH_WO)
    run_phase<PH_WO>(p, lds); xcd_barrier(bar);
#endif
    run_phase<PH_LN3R>(p, lds); xcd_barrier(bar);
#if defined(DUP_PH_LN3R)
    run_phase<PH_LN3R>(p, lds); xcd_barrier(bar);
#endif
    run_phase<PH_MAP>(p, lds); xcd_barrier(bar);
#if defined(DUP_PH_MAP)
    run_phase<PH_MAP>(p, lds); xcd_barrier(bar);
#endif
    run_phase<PH_MUP_A>(p, lds); xcd_barrier(bar);
#if defined(DUP_PH_MUP_A)
    run_phase<PH_MUP_A>(p, lds); xcd_barrier(bar);
#endif
    run_phase<PH_MDN_A>(p, lds); xcd_barrier(bar);
#if defined(DUP_PH_MDN_A)
    run_phase<PH_MDN_A>(p, lds); xcd_barrier(bar);
#endif
    run_phase<PH_MUP_B>(p, lds); xcd_barrier(bar);
#if defined(DUP_PH_MUP_B)
    run_phase<PH_MUP_B>(p, lds); xcd_barrier(bar);
#endif
    run_phase<PH_MDN_B>(p, lds); xcd_barrier(bar);
#if defined(DUP_PH_MDN_B)
    run_phase<PH_MDN_B>(p, lds); xcd_barrier(bar);
#endif
    run_phase<PH_FINAL>(p, lds);
}
template <int PH> static void launch_phase(const Params& p, hipStream_t stream) {
    static bool attr_done = false;
    if (!attr_done) { attr_done = true; (void)hipFuncSetAttribute((const void*)k_ph<PH>, hipFuncAttributeMaxDynamicSharedMemorySize, LDS_BYTES); }
    k_ph<PH><<<256, NTHR, LDS_BYTES, stream>>>(p);
}
static void build_cvt(CvtTable& tb, const Params& p) {
    int n = 0, tile = 0;
    auto add = [&](const float* s0, const float* s1, bf16_t* dst, int K, int N, int ld, int mode) { CvtJob& j = tb.j[n++]; j.src0 = s0; j.src1 = s1; j.dst = dst; j.K = K; j.N = N; j.ld = ld; j.mode = mode; j.tile0 = tile; j.pad = 0; tile += (N / 64) * (K / 128); };
    add(p.a_w_in, nullptr, p.Wt_in, DM, 4096, NPROJ, 0);
    add(p.a_w_out, nullptr, p.Wt_out, DM, DM, DM, 0);
    add(p.ffn_w1, p.ffn_w3, p.Wt_13, DM, 2 * FF, FF, 1);
    add(p.ffn_w2, nullptr, p.Wt_2, FF, DM, DM, 0);
    add(p.b_w_kv, nullptr, p.Wt_kvq, DM, 1024, 2048, 2);
    add(p.b_w_kv + 1024, nullptr, p.Wt_kvq + (size_t)1024 * DM, DM, 1024, 2048, 0);
    add(p.b_w_q, nullptr, p.Wt_kvq + (size_t)2048 * DM, DM, 1024, DM, 2);
    add(p.b_w_o, nullptr, p.Wt_o, DM, DM, DM, 0);
    for (int e = 0; e < NE; ++e) add(p.moe_w1 + (size_t)e * DM * FF, p.moe_w3 + (size_t)e * DM * FF, p.Wt_m13 + (size_t)e * 2 * FF * DM, DM, 2 * FF, FF, 1);
    for (int e = 0; e < NE; ++e) add(p.moe_w2 + (size_t)e * FF * DM, nullptr, p.Wt_m2 + (size_t)e * DM * FF, FF, DM, DM, 0);
    tb.ntiles = tile; tb.pad = 0;
}

extern "C" void kernel_launch(void* const* d_in, const int* in_sizes, int n_in, void* d_out, int out_size, void* d_ws, size_t ws_size, hipStream_t stream) {
    static Params p;
    p.x = (const float*)d_in[0]; p.a_w_in = (const float*)d_in[1]; p.a_conv_w = (const float*)d_in[2]; p.a_log = (const float*)d_in[3]; p.a_dt = (const float*)d_in[4];
    p.a_norm_w = (const float*)d_in[5]; p.a_w_out = (const float*)d_in[6]; p.b_w_kv = (const float*)d_in[7]; p.b_w_q = (const float*)d_in[8]; p.b_w_o = (const float*)d_in[9];
    p.ffn_w1 = (const float*)d_in[10]; p.ffn_w3 = (const float*)d_in[11]; p.ffn_w2 = (const float*)d_in[12]; p.moe_router = (const float*)d_in[13];
    p.moe_w1 = (const float*)d_in[14]; p.moe_w3 = (const float*)d_in[15]; p.moe_w2 = (const float*)d_in[16]; p.ln_g = (const float*)d_in[17]; p.ln_b = (const float*)d_in[18];
    p.out = (float*)d_out;
    char* ws = (char*)d_ws; size_t o = 0;
    auto take = [&](size_t bytes) { char* r = ws + o; o += (bytes + 255) & ~(size_t)255; return r; };
    p.Wt_in = (bf16_t*)take((size_t)4096 * DM * 2); p.Wt_out = (bf16_t*)take((size_t)DM * DM * 2); p.Wt_13 = (bf16_t*)take((size_t)2 * FF * DM * 2); p.Wt_2 = (bf16_t*)take((size_t)DM * FF * 2);
    p.Wt_kvq = (bf16_t*)take((size_t)3072 * DM * 2); p.Wt_o = (bf16_t*)take((size_t)DM * DM * 2);
    p.Wt_m13 = (bf16_t*)take((size_t)NE * 2 * FF * DM * 2); p.Wt_m2 = (bf16_t*)take((size_t)NE * DM * FF * 2);
    p.g = (float*)take((size_t)NT * 8 * 4); p.beta = (float*)take((size_t)NT * 8 * 4); p.cs = (float*)take((size_t)SEQ * 64 * 4); p.sn = (float*)take((size_t)SEQ * 64 * 4);
    p.kmp = (float*)take((size_t)64 * 8 * 2 * 128 * 4); p.te = (int*)take((size_t)NT * 2 * 4); p.tg = (float*)take((size_t)NT * 2 * 4); p.pos_of = (int*)take((size_t)NT * 2 * 4); p.slot_of = (int*)take((size_t)NT * 2 * 4);
    p.tok_of_slot = (int*)take((size_t)MAXSLOT * 4); p.gate_of_slot = (float*)take((size_t)MAXSLOT * 4); p.gcnt = (int*)take(256); p.bar = (unsigned*)take(XCD_BAR_WORDS * sizeof(unsigned));
    const size_t U = (size_t)NT * DM * 4;
    char* act = take(4 * U);
    if (o > ws_size) { fprintf(stderr, "workspace too small: need %zu have %zu\n", o, ws_size); return; }
    p.xb = (bf16_t*)act; p.proj = (bf16_t*)(act + U / 2); p.of = p.out; p.ogb = (bf16_t*)(act + 2 * U + U / 2);
    p.ypre = p.out; p.x1 = (float*)act; p.x1b = (bf16_t*)(act + U); p.hidb = (bf16_t*)(act + U + U / 2);
    p.x2 = (float*)act; p.x2b = (bf16_t*)(act + U);
    p.Kb = (bf16_t*)(act + U + U / 2); p.Vb = (bf16_t*)(act + 2 * U); p.Qb = (bf16_t*)(act + 2 * U + U / 2); p.attb = (bf16_t*)(act + 3 * U);
    p.x3 = p.out; p.x3b = (bf16_t*)p.Wt_in;
    p.ysb = (bf16_t*)act; p.hidm = (bf16_t*)(act + (size_t)MAXSLOT * DM * 2); p.ysp = (float*)(act + (size_t)MAXSLOT * DM * 2 + (size_t)18432 * FF * 2);
    build_cvt(p.cvt, p); p.cvt_split = p.cvt.j[8].tile0; p.cvt_split0 = p.cvt.j[1].tile0;
    p.dnout = (unsigned char*)p.Wt_m13;
    static int grid = 0;
    if (!grid) {
        int dev = 0, cus = 0, per_cu = 0;
        (void)hipGetDevice(&dev); (void)hipDeviceGetAttribute(&cus, hipDeviceAttributeMultiprocessorCount, dev);
        (void)hipFuncSetAttribute((const void*)k_mega, hipFuncAttributeMaxDynamicSharedMemorySize, LDS_BYTES);
        (void)hipOccupancyMaxActiveBlocksPerMultiprocessor(&per_cu, (const void*)k_mega, NTHR, LDS_BYTES);
        grid = (cus >= 256 && per_cu >= 1) ? 256 : -1;
        if (grid < 0) fprintf(stderr, "kernel_launch: need 256 CUs with one resident 512-thread workgroup each (cus %d, per_cu %d)\n", cus, per_cu);
    }
    if (grid < 0) return;
    (void)hipMemsetAsync(p.bar, 0, XCD_BAR_WORDS * sizeof(unsigned), stream);
    k_mega<<<grid, NTHR, LDS_BYTES, stream>>>(p);
}
```
